# Optimizing an MI355X kernel written in HIP

```python
import jax, jax.numpy as jnp
from jax import lax
import numpy as np

D_MODEL = 4096
BATCH = 2
SEQ = 4096
DEPTH = 1
DEC_BATCH = 4
DEC_SEQ = 2048
PAST_LEN = 128

N_META = 16
MIX_WIDTH = D_MODEL
GLA_WIDTH = MIX_WIDTH // 2
CONV_WIDTH = MIX_WIDTH - GLA_WIDTH
GLA_HEADS = 8
GLA_DV = GLA_WIDTH // GLA_HEADS
GLA_DK = GLA_DV // 2
GLA_KEY_WIDTH = GLA_HEADS * GLA_DK
GATE_RANK = 16
GATE_TAU = 16.0
CHUNK = 64
META_PAD = CHUNK - N_META
CONV_GROUPS = 16
D_FF = 11008
EPS = 1e-6
IN_SIZES = (GLA_KEY_WIDTH, GLA_KEY_WIDTH, GLA_WIDTH, GLA_WIDTH, GATE_RANK, GATE_RANK,
            CONV_WIDTH, CONV_WIDTH, CONV_WIDTH)
IN_COLS = 2 * GLA_KEY_WIDTH + 2 * GLA_WIDTH + 2 * GATE_RANK + 3 * CONV_WIDTH

kernel_name = "hymba_gla_shortconv_encoder"


def _rmsnorm(x, g):
    xf = x.astype(jnp.float32)
    y = xf * lax.rsqrt(jnp.mean(xf * xf, axis=-1, keepdims=True) + EPS)
    return (y * g.astype(jnp.float32)).astype(x.dtype)


def _dwconv3(u, w):
    up = jnp.pad(u, ((0, 0), (1, 1), (0, 0)))
    w = w.astype(u.dtype)
    return up[:, :-2] * w[0] + up[:, 1:-1] * w[1] + up[:, 2:] * w[2]


def _split(p, sizes):
    outs, off = [], 0
    for s in sizes:
        outs.append(p[..., off:off + s])
        off += s
    return outs


def _gla_scan(q, k, v, lg):
    z, b, lp, h, dk = q.shape
    dv = v.shape[-1]
    n = lp // CHUNK

    def chunks(t):
        return t.astype(jnp.float32).reshape(z, b, n, CHUNK, h, t.shape[-1]).transpose(2, 0, 1, 4, 3, 5)

    tri = jnp.tril(jnp.ones((CHUNK, CHUNK), dtype=bool))
    mask = jnp.stack([tri, jnp.tril(tri, -1)])[:, None, None, :, :, None]

    def step(state, inp):
        qc, kc, vc, gc = inp
        bcum = jnp.cumsum(gc, axis=-2)
        diff = bcum[..., :, None, :] - bcum[..., None, :, :]
        decay = jnp.exp(jnp.where(mask, diff, -jnp.inf))
        scores = jnp.einsum('zbhtd,zbhsd,zbhtsd->zbhts', qc, kc, decay)
        out = (jnp.einsum('zbhts,zbhsv->zbhtv', scores, vc)
               + jnp.einsum('zbhtd,zbhdv->zbhtv', qc * jnp.exp(bcum), state))
        blast = bcum[..., -1:, :]
        state = (jnp.exp(blast[..., 0, :])[..., None] * state
                 + jnp.einsum('zbhsd,zbhsv->zbhdv', kc * jnp.exp(blast - bcum), vc))
        return state, out

    s0 = jnp.zeros((z, b, h, dk, dv), jnp.float32)
    _, o = lax.scan(step, s0, (chunks(q), chunks(k), chunks(v), chunks(lg)))
    return o.transpose(1, 2, 0, 4, 3, 5).reshape(z, b, lp, h, dv)


def _layer(x, mix_norm_g, w_in, w_gate2, b_gate2, head_norm_g, conv_mix_w, w_out,
           ffn_norm_g, w_up, ffn_conv_w, ffn_conv_b, w_down):
    bsz, length, _ = x.shape
    h = _rmsnorm(x, mix_norm_g)
    q, k, v, r, a_f, a_b, cb, cc, ch = _split(h @ w_in, IN_SIZES)

    q = q.reshape(bsz, length, GLA_HEADS, GLA_DK) * (GLA_DK ** -0.5)
    k = k.reshape(bsz, length, GLA_HEADS, GLA_DK)
    v = v.reshape(bsz, length, GLA_HEADS, GLA_DV)
    lg_f = (jax.nn.log_sigmoid((a_f @ w_gate2[0] + b_gate2[0]).astype(jnp.float32)) / GATE_TAU
            ).reshape(bsz, length, GLA_HEADS, GLA_DK)
    lg_b = (jax.nn.log_sigmoid((a_b @ w_gate2[1] + b_gate2[1]).astype(jnp.float32)) / GATE_TAU
            ).reshape(bsz, length, GLA_HEADS, GLA_DK)
    pad = ((0, 0), (META_PAD, 0), (0, 0), (0, 0))

    def both(tf, tb):
        return jnp.stack([jnp.pad(tf, pad), jnp.pad(tb, pad)[:, ::-1]])

    o2 = _gla_scan(both(q, q), both(k, k), both(v, v), both(lg_f, lg_b))
    o = (o2[0] + o2[1][:, ::-1])[:, META_PAD:]
    o = _rmsnorm(o, head_norm_g).reshape(bsz, length, GLA_WIDTH).astype(x.dtype) * jax.nn.silu(r)

    conv_out = cb * _dwconv3(cc * ch, conv_mix_w)

    x = x + jnp.concatenate([o, conv_out], axis=-1) @ w_out

    h2 = _rmsnorm(x, ffn_norm_g)
    u, g = jnp.split(h2 @ w_up, 2, axis=-1)
    g = _dwconv3(g, ffn_conv_w) + ffn_conv_b
    return x + (jax.nn.silu(g) * u) @ w_down


def _trunk(x, meta_tokens, mix_norm_g, w_in, w_gate2, b_gate2, head_norm_g, conv_mix_w, w_out,
           ffn_norm_g, w_up, ffn_conv_w, ffn_conv_b, w_down, final_norm_g):
    bsz = x.shape[0]
    meta = jnp.broadcast_to(meta_tokens.astype(x.dtype)[None], (bsz, N_META, x.shape[-1]))
    hs = jnp.concatenate([meta, x], axis=1)
    for l in range(DEPTH):
        hs = _layer(hs, mix_norm_g[l], w_in[l], w_gate2[l], b_gate2[l], head_norm_g[l],
                    conv_mix_w[l], w_out[l], ffn_norm_g[l], w_up[l], ffn_conv_w[l],
                    ffn_conv_b[l], w_down[l])
    hs = _rmsnorm(hs, final_norm_g)
    return hs[:, N_META:]


def setup_inputs(seed: int = 0) -> dict:
    key = jax.random.key(seed)
    ks = jax.random.split(key, 16)
    f32 = jnp.float32
    nrm = lambda k, s: jax.random.normal(k, s, f32)
    return {
        "x_prompt": nrm(ks[0], (BATCH, SEQ, D_MODEL)),
        "x_sample": nrm(ks[1], (DEC_BATCH, DEC_SEQ, D_MODEL)),
        "meta_tokens": nrm(ks[2], (N_META, D_MODEL)),
        "mix_norm_g": 1.0 + 0.01 * nrm(ks[3], (DEPTH, D_MODEL)),
        "w_in": nrm(ks[4], (DEPTH, D_MODEL, IN_COLS)) * D_MODEL ** -0.5,
        "w_gate2": nrm(ks[5], (DEPTH, 2, GATE_RANK, GLA_KEY_WIDTH)) * GATE_RANK ** -0.5,
        "b_gate2": 0.1 * nrm(ks[6], (DEPTH, 2, GLA_KEY_WIDTH)),
        "head_norm_g": 1.0 + 0.01 * nrm(ks[7], (DEPTH, GLA_DV)),
        "conv_mix_w": nrm(ks[8], (DEPTH, 3, CONV_WIDTH)) * 3.0 ** -0.5,
        "w_out": nrm(ks[9], (DEPTH, MIX_WIDTH, D_MODEL)) * MIX_WIDTH ** -0.5,
        "ffn_norm_g": 1.0 + 0.01 * nrm(ks[10], (DEPTH, D_MODEL)),
        "w_up": nrm(ks[11], (DEPTH, D_MODEL, 2 * D_FF)) * D_MODEL ** -0.5,
        "ffn_conv_w": nrm(ks[12], (DEPTH, 3, D_FF)) * 3.0 ** -0.5,
        "ffn_conv_b": 0.01 * nrm(ks[13], (DEPTH, D_FF)),
        "w_down": nrm(ks[14], (DEPTH, D_FF, D_MODEL)) * D_FF ** -0.5,
        "final_norm_g": 1.0 + 0.01 * nrm(ks[15], (D_MODEL,)),
    }


def reference(x_prompt, x_sample, meta_tokens, mix_norm_g, w_in, w_gate2, b_gate2, head_norm_g,
              conv_mix_w, w_out, ffn_norm_g, w_up, ffn_conv_w, ffn_conv_b, w_down, final_norm_g):
    y_prompt = _trunk(x_prompt, meta_tokens, mix_norm_g, w_in, w_gate2, b_gate2, head_norm_g,
                      conv_mix_w, w_out, ffn_norm_g, w_up, ffn_conv_w, ffn_conv_b, w_down,
                      final_norm_g)
    y_sample = _trunk(x_sample, meta_tokens, mix_norm_g, w_in, w_gate2, b_gate2, head_norm_g,
                      conv_mix_w, w_out, ffn_norm_g, w_up, ffn_conv_w, ffn_conv_b, w_down,
                      final_norm_g)
    return (y_prompt, y_sample)
```

```cpp
#include <hip/hip_runtime.h>
#include <cstdio>
#include <cstdint>
#define MK_ONE_LAUNCH 1
namespace pg8 {
#define PG8_LAS __attribute__((address_space(3)))
typedef unsigned short bf16_t;
typedef short bf16x8 __attribute__((ext_vector_type(8)));
typedef float f32x4 __attribute__((ext_vector_type(4)));
typedef unsigned u32x4 __attribute__((ext_vector_type(4)));
constexpr int BM = 256, BK = 64, HALF = 128, HTB = HALF * BK * 2  , STAGE_BYTES = 8 * HTB, NXCD = 8, WGM = 8;

__host__ __device__ __forceinline__ int lds_byte(int r, int c) { const int st = (r >> 4) * 2 + (c >> 5), rr = r & 15, cc = c & 31, ob = rr * 64 + cc * 2; return st * 1024 + (ob ^ (((ob >> 9) & 1) << 5)); }
__host__ __device__ __forceinline__ void stage_rc(int b, int& R, int& C) { const int st = b / 1024, sb = b % 1024, swz = sb ^ (((sb >> 9) & 1) << 5); R = (st >> 1) * 16 + swz / 64; C = (st & 1) * 32 + (swz % 64) / 2; }
__host__ __device__ __forceinline__ int perm32(int rho) { const int n = rho >> 4, i = rho & 15; return 8 * (i >> 2) + 4 * n + (i & 3); }

struct Unit { int pm, pn; };
struct Gemm { const bf16_t* A; const bf16_t* Bt; int M, N, K; };

struct StaticOrder {
    int nM, nN, nwg, G, c;
    __host__ __device__ void init(int M, int N, int G_, int c_) { nM = M / BM; nN = N / BM; nwg = nM * nN; G = G_; c = c_; }
    __host__ __device__ bool next(int i, Unit& u) const {
        const long L = (long)i * G + c; if (L >= nwg) return false;
        int wgid = (int)L; { const int q = nwg / NXCD, r = nwg % NXCD, xcd = wgid % NXCD, off = wgid / NXCD; wgid = (xcd < r ? xcd * (q + 1) : r * (q + 1) + (xcd - r) * q) + off; }
        const int nig = WGM * nN, gid = wgid / nig, fm = gid * WGM, gsz = (nM - fm) < WGM ? (nM - fm) : WGM;
        u.pm = fm + ((wgid % nig) % gsz); u.pn = (wgid % nig) / gsz; return true;
    }
    __device__ __forceinline__ void a_ready(const Unit&) const {}
    __device__ __forceinline__ void done(const Unit&) const {}
};

__device__ __forceinline__ unsigned cvt_pk_bf16(float lo, float hi) { unsigned r; asm volatile("v_cvt_pk_bf16_f32 %0, %1, %2" : "=v"(r) : "v"(lo), "v"(hi)); return r; }
typedef float f32x2 __attribute__((ext_vector_type(2)));
struct EpiIn {
    static constexpr bool PERM = true, AFTER_DRAIN = false;
    bf16_t *PQK, *PV, *PR, *PC; float* AD;
    __device__ __forceinline__ void operator()(const f32x4 (&acc)[2][2][4][2], const Unit& u, int wr, int wc, int fr, int fq) const {
        const int row0 = u.pm * BM + wr * 64 + fr; const int pn = u.pn;
        if (pn < 48) {
            bf16_t* base; int ldc, colt;
            if (pn < 8) { base = PQK; ldc = 2048; colt = pn * 256; }
            else if (pn < 16) { base = PV; ldc = 2048; colt = (pn - 8) * 256; }
            else if (pn < 24) { base = PR; ldc = 2048; colt = (pn - 16) * 256; }
            else { base = PC; ldc = 6144; colt = (pn - 24) * 256; }
            const int col0 = colt + wc * 32 + 8 * fq;
#pragma unroll
            for (int ai = 0; ai < 2; ++ai)
#pragma unroll
                for (int m = 0; m < 4; ++m) { bf16_t* rowp = base + (size_t)(row0 + ai * HALF + m * 16) * ldc + col0;
#pragma unroll
                    for (int bj = 0; bj < 2; ++bj) { const f32x4 v0 = acc[ai][bj][m][0], v1 = acc[ai][bj][m][1];
                        u32x4 w; w.x = cvt_pk_bf16(v0[0], v0[1]); w.y = cvt_pk_bf16(v0[2], v0[3]); w.z = cvt_pk_bf16(v1[0], v1[1]); w.w = cvt_pk_bf16(v1[2], v1[3]);
                        *(u32x4*)(rowp + bj * HALF) = w; } }
        } else if (wc == 0) {
#pragma unroll
            for (int ai = 0; ai < 2; ++ai)
#pragma unroll
                for (int m = 0; m < 4; ++m) { float* rowp = AD + (size_t)(row0 + ai * HALF + m * 16) * 32 + 8 * fq;
#pragma unroll
                    for (int n = 0; n < 2; ++n) *(f32x4*)(rowp + 4 * n) = acc[ai][0][m][n]; }
        }
    }
};
struct EpiBf16Plain {
    static constexpr bool PERM = true, AFTER_DRAIN = false;
    bf16_t* O; int ldc;
    __device__ __forceinline__ void operator()(const f32x4 (&acc)[2][2][4][2], const Unit& u, int wr, int wc, int fr, int fq) const {
        const int row0 = u.pm * BM + wr * 64 + fr, col0 = u.pn * BM + wc * 32 + 8 * fq;
#pragma unroll
        for (int ai = 0; ai < 2; ++ai)
#pragma unroll
            for (int m = 0; m < 4; ++m) { bf16_t* rowp = O + (size_t)(row0 + ai * HALF + m * 16) * ldc + col0;
#pragma unroll
                for (int bj = 0; bj < 2; ++bj) { const f32x4 v0 = acc[ai][bj][m][0], v1 = acc[ai][bj][m][1];
                    u32x4 w; w.x = cvt_pk_bf16(v0[0], v0[1]); w.y = cvt_pk_bf16(v0[2], v0[3]); w.z = cvt_pk_bf16(v1[0], v1[1]); w.w = cvt_pk_bf16(v1[2], v1[3]);
                    *(u32x4*)(rowp + bj * HALF) = w; } }
    }
};
struct EpiOut {
    static constexpr bool PERM = false, AFTER_DRAIN = false;
    const float *xp, *xs, *meta; float *out, *x1m;
    __device__ __forceinline__ void operator()(const f32x4 (&acc)[2][2][4][2], const Unit& u, int wr, int wc, int fr, int fq) const {
        const int row0 = u.pm * BM + wr * 64 + fr, col0 = u.pn * BM + wc * 32 + 4 * fq;
#pragma unroll
        for (int ai = 0; ai < 2; ++ai)
#pragma unroll
            for (int m = 0; m < 4; ++m) { const int row = row0 + ai * HALF + m * 16;
                if (row < 16480) { const float* src; float* dst;
                    if (row < 8192) { src = xp + (size_t)row * 4096; dst = out + (size_t)row * 4096; }
                    else if (row < 16384) { src = xs + (size_t)(row - 8192) * 4096; dst = out + (size_t)row * 4096; }
                    else { src = meta + (size_t)((row - 16384) & 15) * 4096; dst = x1m + (size_t)(row - 16384) * 4096; }
#pragma unroll
                    for (int bj = 0; bj < 2; ++bj)
#pragma unroll
                        for (int n = 0; n < 2; ++n) { const int off = col0 + bj * HALF + n * 16; *(f32x4*)(dst + off) = *(const f32x4*)(src + off) + acc[ai][bj][m][n]; } } }
    }
};
struct EpiDown {
    static constexpr bool PERM = false, AFTER_DRAIN = false;
    float* out;
    __device__ __forceinline__ void operator()(const f32x4 (&acc)[2][2][4][2], const Unit& u, int wr, int wc, int fr, int fq) const {
        const int row0 = u.pm * BM + wr * 64 + fr, col0 = u.pn * BM + wc * 32 + 4 * fq;
#pragma unroll
        for (int ai = 0; ai < 2; ++ai)
#pragma unroll
            for (int m = 0; m < 4; ++m) { float* rowp = out + (size_t)(row0 + ai * HALF + m * 16) * 4096 + col0;
#pragma unroll
                for (int bj = 0; bj < 2; ++bj)
#pragma unroll
                    for (int n = 0; n < 2; ++n) { float* p = rowp + bj * HALF + n * 16; *(f32x4*)p = *(const f32x4*)p + acc[ai][bj][m][n]; } }
    }
};

template <class Epi, class Sched, bool ALIGN_EPI = false, bool SP2 = false>
__device__ __forceinline__ void gemm_phase(PG8_LAS unsigned char* lds, const Gemm g, const Sched& S, const Epi& E) {
    const int tid = threadIdx.x, wid = __builtin_amdgcn_readfirstlane(tid >> 6), lane = tid & 63, wr = wid >> 2, wc = wid & 3, fr = lane & 15, fq = lane >> 4;
    const int K = g.K, nt = K / BK;
    unsigned voffA[2], voffB[2];
#pragma unroll
    for (int i = 0; i < 2; ++i) { int R, C; stage_rc(tid * 16 + i * 8192, R, C); const int Rb = Epi::PERM ? ((R & ~31) + perm32(R & 31)) : R;
        voffA[i] = (unsigned)(R * K + C) * 2u; voffB[i] = (unsigned)(Rb * K + C) * 2u; }
    const size_t kstep = (size_t)(BK * 2);
    const size_t hstep = (size_t)HALF * K * 2;
    const size_t tstep = 2 * hstep;
    const unsigned ldsw = (unsigned)wid * 1024u;
    const int aoff = lds_byte(wr * 64 + fr, fq * 8), boff = lds_byte(wc * 32 + fr, fq * 8);
#define PG8_SA(b, h) (((b) * 2 + (h)) * HTB)
#define PG8_SB(b, h) ((4 + (b) * 2 + (h)) * HTB)
#define PG8_STAGE(bufoff, gbase, voff) do { _Pragma("unroll") for (int _i = 0; _i < 2; ++_i) \
        __builtin_amdgcn_global_load_lds((const unsigned*)((const char*)(gbase) + (voff)[_i]), (PG8_LAS unsigned*)(lds + (bufoff) + ldsw + _i * 8192), 16, 0, 0); } while (0)
#define PG8_LDA(dst, b, h) do { _Pragma("unroll") for (int m = 0; m < 4; ++m) _Pragma("unroll") for (int k = 0; k < 2; ++k) dst[m][k] = *(const PG8_LAS bf16x8*)(lds + PG8_SA(b, h) + aoff + m * 2048 + k * 1024); } while (0)
#define PG8_LDB(dst, b, h) do { _Pragma("unroll") for (int n = 0; n < 2; ++n) _Pragma("unroll") for (int k = 0; k < 2; ++k) dst[n][k] = *(const PG8_LAS bf16x8*)(lds + PG8_SB(b, h) + boff + n * 2048 + k * 1024); } while (0)
#define PG8_MMA(ai, bj, At, Bt) do { __builtin_amdgcn_s_setprio(1); _Pragma("unroll") for (int m = 0; m < 4; ++m) _Pragma("unroll") for (int n = 0; n < 2; ++n) _Pragma("unroll") for (int k = 0; k < 2; ++k) \
        acc[ai][bj][m][n] = __builtin_amdgcn_mfma_f32_16x16x32_bf16(Bt[n][k], At[m][k], acc[ai][bj][m][n], 0, 0, 0); __builtin_amdgcn_s_setprio(0); } while (0)
#define PG8_WAIT_V(n) asm volatile("s_waitcnt vmcnt(" #n ")" ::: "memory")
#define PG8_WAIT_L(n) asm volatile("s_waitcnt lgkmcnt(" #n ")" ::: "memory")
#define PG8_BAR __builtin_amdgcn_s_barrier()
#define PG8_SCHED __builtin_amdgcn_sched_barrier(0)
    Unit cur, nxt; int ui = 0;
    if (!S.next(0, cur)) return;
    f32x4 acc[2][2][4][2];
#pragma unroll
    for (int a = 0; a < 2; ++a)
#pragma unroll
        for (int b = 0; b < 2; ++b)
#pragma unroll
            for (int m = 0; m < 4; ++m)
#pragma unroll
                for (int n = 0; n < 2; ++n) acc[a][b][m][n] = (f32x4){0.f, 0.f, 0.f, 0.f};
    bf16x8 At[4][2], B0[2][2], B1[2][2];
    const char* cA = (const char*)g.A + (size_t)cur.pm * tstep; const char* cB = (const char*)g.Bt + (size_t)cur.pn * tstep;
    S.a_ready(cur);
    if constexpr (SP2) {
        PG8_STAGE(PG8_SB(0, 0), cB, voffB); PG8_STAGE(PG8_SB(0, 1), cB + hstep, voffB); PG8_STAGE(PG8_SA(0, 0), cA, voffA); PG8_STAGE(PG8_SA(0, 1), cA + hstep, voffA);
        if (wr == 1) PG8_BAR;
        PG8_WAIT_V(2); PG8_BAR;
        PG8_STAGE(PG8_SB(1, 0), cB + kstep, voffB); PG8_STAGE(PG8_SA(1, 0), cA + kstep, voffA); PG8_STAGE(PG8_SB(1, 1), cB + hstep + kstep, voffB);
        PG8_WAIT_V(6); PG8_BAR;
    } else {
        PG8_STAGE(PG8_SB(0, 0), cB, voffB); PG8_STAGE(PG8_SA(0, 0), cA, voffA); PG8_STAGE(PG8_SB(0, 1), cB + hstep, voffB); PG8_STAGE(PG8_SA(0, 1), cA + hstep, voffA);
        if (wr == 1) PG8_BAR;
        PG8_WAIT_V(4); PG8_BAR;
        PG8_STAGE(PG8_SB(1, 0), cB + kstep, voffB); PG8_STAGE(PG8_SA(1, 0), cA + kstep, voffA); PG8_STAGE(PG8_SB(1, 1), cB + hstep + kstep, voffB);
        PG8_WAIT_V(6); PG8_BAR;
    }
    for (;;) {
        const bool has_next = S.next(ui + 1, nxt);
        const char* nA = has_next ? (const char*)g.A + (size_t)nxt.pm * tstep : cA; const char* nB = has_next ? (const char*)g.Bt + (size_t)nxt.pn * tstep : cB;
        for (int t = 0; t < nt; t += 2) {
            const bool last = (t == nt - 2);
            const char* a1 = cA + (size_t)(t + 1) * kstep;
            const char* a2 = last ? nA : cA + (size_t)(t + 2) * kstep; const char* b2 = last ? nB : cB + (size_t)(t + 2) * kstep;
            const char* a3 = a2 + kstep; const char* b3 = b2 + kstep;
            if (last && has_next) S.a_ready(nxt);
            if constexpr (SP2) {
            PG8_LDB(B0, 0, 0); PG8_LDB(B1, 0, 1); PG8_SCHED; PG8_LDA(At, 0, 0); PG8_STAGE(PG8_SA(1, 1), a1 + hstep, voffA);
            PG8_WAIT_V(8); PG8_WAIT_L(0); PG8_BAR; PG8_MMA(0, 0, At, B0); PG8_MMA(0, 1, At, B1); PG8_BAR; PG8_SCHED;
            PG8_LDA(At, 0, 1); PG8_STAGE(PG8_SB(0, 0), b2, voffB); PG8_STAGE(PG8_SB(0, 1), b2 + hstep, voffB); PG8_STAGE(PG8_SA(0, 0), a2, voffA);
            PG8_WAIT_V(8); PG8_WAIT_L(0); PG8_BAR; PG8_MMA(1, 0, At, B0); PG8_MMA(1, 1, At, B1); PG8_BAR; PG8_SCHED;
            PG8_LDB(B0, 1, 0); PG8_LDB(B1, 1, 1); PG8_SCHED; PG8_LDA(At, 1, 0); PG8_STAGE(PG8_SA(0, 1), a2 + hstep, voffA);
            PG8_WAIT_V(8); PG8_WAIT_L(0); PG8_BAR; PG8_MMA(0, 0, At, B0); PG8_MMA(0, 1, At, B1); PG8_BAR; PG8_SCHED;
            PG8_LDA(At, 1, 1); PG8_STAGE(PG8_SB(1, 0), b3, voffB); PG8_STAGE(PG8_SB(1, 1), b3 + hstep, voffB); PG8_STAGE(PG8_SA(1, 0), a3, voffA);
            PG8_WAIT_V(8); PG8_WAIT_L(0); PG8_BAR; PG8_MMA(1, 0, At, B0); PG8_MMA(1, 1, At, B1); PG8_BAR; PG8_SCHED;
            } else {
            PG8_LDB(B0, 0, 0); PG8_SCHED; PG8_LDA(At, 0, 0); PG8_STAGE(PG8_SA(1, 1), a1 + hstep, voffA);
            PG8_WAIT_L(8); PG8_BAR; PG8_WAIT_L(0); PG8_MMA(0, 0, At, B0); PG8_BAR; PG8_SCHED;
            PG8_LDB(B1, 0, 1); PG8_STAGE(PG8_SB(0, 0), b2, voffB);
            PG8_BAR; PG8_WAIT_L(0); PG8_MMA(0, 1, At, B1); PG8_BAR;
            PG8_LDA(At, 0, 1); PG8_STAGE(PG8_SA(0, 0), a2, voffA);
            PG8_BAR; PG8_WAIT_L(0); PG8_MMA(1, 0, At, B0); PG8_BAR; PG8_SCHED;
            PG8_STAGE(PG8_SB(0, 1), b2 + hstep, voffB);
            PG8_WAIT_V(6); PG8_BAR; PG8_MMA(1, 1, At, B1); PG8_BAR;
            PG8_LDB(B0, 1, 0); PG8_SCHED; PG8_LDA(At, 1, 0); PG8_STAGE(PG8_SA(0, 1), a2 + hstep, voffA);
            PG8_WAIT_L(8); PG8_BAR; PG8_WAIT_L(0); PG8_MMA(0, 0, At, B0); PG8_BAR; PG8_SCHED;
            PG8_LDB(B1, 1, 1); PG8_STAGE(PG8_SB(1, 0), b3, voffB);
            PG8_BAR; PG8_WAIT_L(0); PG8_MMA(0, 1, At, B1); PG8_BAR;
            PG8_LDA(At, 1, 1); PG8_STAGE(PG8_SA(1, 0), a3, voffA);
            PG8_BAR; PG8_WAIT_L(0); PG8_MMA(1, 0, At, B0); PG8_BAR; PG8_SCHED;
            PG8_STAGE(PG8_SB(1, 1), b3 + hstep, voffB);
            PG8_WAIT_V(6); PG8_BAR; PG8_MMA(1, 1, At, B1); PG8_BAR;
            }
        }
        if constexpr (ALIGN_EPI) { if (wr == 0) PG8_BAR; }
        if constexpr (!Epi::AFTER_DRAIN) { E(acc, cur, wr, wc, fr, fq); S.done(cur); }
        if (!has_next) break;
#pragma unroll
        for (int a = 0; a < 2; ++a)
#pragma unroll
            for (int b = 0; b < 2; ++b)
#pragma unroll
                for (int m = 0; m < 4; ++m)
#pragma unroll
                    for (int n = 0; n < 2; ++n) acc[a][b][m][n] = (f32x4){0.f, 0.f, 0.f, 0.f};
        cur = nxt; cA = nA; cB = nB; ++ui;
        if constexpr (ALIGN_EPI) { if (wr == 1) PG8_BAR; }
    }
    PG8_WAIT_V(0);
    if constexpr (!ALIGN_EPI) { if (wr == 0) PG8_BAR; }
    PG8_BAR;
    if constexpr (Epi::AFTER_DRAIN) { E.fused(acc, cur, wr, wc, fr, fq, lds, wid, lane); S.done(cur); }
#undef PG8_SA
#undef PG8_SB
#undef PG8_STAGE
#undef PG8_LDA
#undef PG8_LDB
#undef PG8_MMA
#undef PG8_WAIT_V
#undef PG8_WAIT_L
#undef PG8_BAR
#undef PG8_SCHED
}
}
#define GAS __attribute__((address_space(1)))
#define LAS __attribute__((address_space(3)))
typedef unsigned short bf16;
typedef unsigned v4u __attribute__((ext_vector_type(4)));
typedef float f32x4 __attribute__((ext_vector_type(4)));
typedef short bf16x8 __attribute__((ext_vector_type(8)));
typedef GAS unsigned gu32;
typedef GAS unsigned long long gu64;
#define RLX_AGENT __ATOMIC_RELAXED, __HIP_MEMORY_SCOPE_AGENT
#define LDS_WAIT() asm volatile("s_waitcnt lgkmcnt(0)" ::: "memory")
#define VM_WAIT() asm volatile("s_waitcnt vmcnt(0)" ::: "memory")
__device__ __forceinline__ unsigned long long rt() { return __builtin_amdgcn_s_memrealtime(); }
__device__ __forceinline__ unsigned f2bf(float f) { unsigned u = __builtin_bit_cast(unsigned, f); return (u + 0x7fffu + ((u >> 16) & 1u)) >> 16; }
__device__ __forceinline__ unsigned pk2(float lo, float hi) { return f2bf(lo) | (f2bf(hi) << 16); }

#define XB_TMO      128
#define XB_XCNT(j)  (256  + 64 * (j))
#define XB_XSUB(j)  (1280 + 64 * (j))
#define XB_XGEN(j)  (2304 + 64 * (j))
#define XB_TOP      3328
#define XB_TOPGEN   3392
#define XCD_BAR_WORDS 3456
#define XB_SPIN_CAP (1u << 18)

__device__ __forceinline__ unsigned xb_ld(unsigned* p)              { return __hip_atomic_load(p, __ATOMIC_RELAXED, __HIP_MEMORY_SCOPE_AGENT); }
__device__ __forceinline__ unsigned xb_add(unsigned* p, unsigned v) { return __hip_atomic_fetch_add(p, v, __ATOMIC_RELAXED, __HIP_MEMORY_SCOPE_AGENT); }
__device__ __forceinline__ unsigned xb_xcc_id() { return (unsigned)__builtin_amdgcn_s_getreg((3 << 11) | 20) & 0xFu; }
#define XB_SPIN(cond, bar) do { unsigned _sp = 0; while (cond) { __builtin_amdgcn_s_sleep(1); \
    if ((++_sp & 255u) == 0u) { if (xb_ld(&(bar)[XB_TMO])) break; if (_sp > XB_SPIN_CAP) { atomicAdd(&(bar)[XB_TMO], 1u); break; } } } } while (0)

struct XcdBarrier {
    unsigned* bar; unsigned x;
    volatile LAS unsigned* st;
};

__device__ __forceinline__ XcdBarrier xcd_barrier_post(unsigned* bar, volatile LAS unsigned* st) {
    XcdBarrier b; b.bar = bar; b.x = xb_xcc_id(); b.st = st;
    if (threadIdx.x == 0) (void)xb_add(&bar[XB_XCNT(b.x)], 1u);
    return b;
}
__device__ __forceinline__ void xcd_barrier_complete(unsigned* bar, unsigned x, unsigned& nloc, unsigned& nx) {
    const unsigned G = gridDim.x * gridDim.y * gridDim.z;
    unsigned sum, cnt, mine, sp = 0u;
    for (;;) {
        sum = 0u; cnt = 0u; mine = 0u;
#pragma unroll
        for (unsigned j = 0; j < 16; ++j) { const unsigned c = xb_ld(&bar[XB_XCNT(j)]); sum += c; cnt += (c > 0u) ? 1u : 0u; mine = (j == x) ? c : mine; }
        if (sum == G) break;
        __builtin_amdgcn_s_sleep(1);
        if ((++sp & 255u) == 0u) { if (xb_ld(&bar[XB_TMO])) break; if (sp > XB_SPIN_CAP) { atomicAdd(&bar[XB_TMO], 1u); break; } }
    }
    nloc = mine > 0u ? mine : 1u; nx = cnt > 0u ? cnt : 1u;
}

__device__ __forceinline__ void xcd_barrier(const XcdBarrier& b) {
    asm volatile("s_waitcnt vmcnt(0)" ::: "memory");
    __syncthreads();
    if (threadIdx.x == 0) {
        unsigned* bar = b.bar;
        __builtin_amdgcn_s_waitcnt(0);
        unsigned nloc = b.st[0], nx = b.st[1];
        if (nloc == 0u) { xcd_barrier_complete(bar, b.x, nloc, nx); b.st[0] = nloc; b.st[1] = nx; }
        const unsigned old = xb_add(&bar[XB_XSUB(b.x)], 1u);
        const unsigned gen = old / nloc;
        if (old + 1u == (gen + 1u) * nloc) {
            __builtin_amdgcn_fence(__ATOMIC_RELEASE, "agent");
            asm volatile("s_waitcnt vmcnt(0)" ::: "memory");
            const unsigned og = xb_add(&bar[XB_TOP], 1u);
            const unsigned tg = og / nx;
            if (og + 1u == (tg + 1u) * nx) xb_add(&bar[XB_TOPGEN], 1u);
            else XB_SPIN(xb_ld(&bar[XB_TOPGEN]) == tg, bar);
            __builtin_amdgcn_fence(__ATOMIC_ACQUIRE, "agent");
            xb_add(&bar[XB_XGEN(b.x)], 1u);
            asm volatile("s_waitcnt vmcnt(0)" ::: "memory");
        } else {
            XB_SPIN(xb_ld(&bar[XB_XGEN(b.x)]) == gen, bar);
            __builtin_amdgcn_fence(__ATOMIC_ACQUIRE, "agent");
            asm volatile("s_waitcnt vmcnt(0)" ::: "memory");
        }
    }
    __syncthreads();
}
constexpr int NWAVES = 8;
constexpr int DM = 4096, DFF = 11008, NUP = 2 * DFF, NI = 12544;
constexpr int MREAL = 16384, MTOK = 16480, MP = 16640;
constexpr int NITEM = 2096;
constexpr int NCSEQ = 262;
constexpr float EPS = 1e-6f;
constexpr size_t MiB = 1u << 20;
constexpr size_t WS_CTL = 0, CTL_ZERO_BYTES = 65536;
constexpr size_t WS_AD = 1 * MiB;
constexpr size_t WS_X1M = 4 * MiB;
constexpr size_t WS_WD = 6 * MiB;
constexpr size_t WS_WI = 92 * MiB;
constexpr size_t WS_WO = 190 * MiB;
constexpr size_t WS_WU = 222 * MiB;
constexpr size_t WS_XN = 394 * MiB;
constexpr size_t WS_PQK = 524 * MiB;
constexpr size_t WS_PC = 589 * MiB;
constexpr size_t WS_PV = 784 * MiB;
constexpr size_t WS_PR = 849 * MiB;
constexpr size_t WS_QT = 914 * MiB;
constexpr size_t WS_KT = 980 * MiB;
constexpr size_t WS_KH = 1046 * MiB;
constexpr size_t WS_ED = 1112 * MiB;
constexpr size_t WS_MIX = 1115 * MiB;
constexpr size_t WS_END = 1245 * MiB;
constexpr size_t WS_O2 = WS_PQK;
constexpr size_t WS_UG = WS_PQK;
constexpr size_t WS_H = WS_WI;
static_assert(WS_UG + (size_t)MP * NUP * 2 <= WS_END && WS_H + (size_t)MP * DFF * 2 <= WS_PQK && WS_O2 + (size_t)2 * MP * 2048 * 2 <= WS_PV, "ws map");
static_assert(WS_QT + (size_t)2 * NITEM * 8192 * 2 <= WS_KT && WS_KH + (size_t)2 * NITEM * 8192 * 2 <= WS_ED && WS_ED + (size_t)2 * NITEM * 128 * 4 <= WS_MIX, "ws map 2");
constexpr int CW_BAR = 4096;
constexpr int RING_BYTES = 131072, MISC_OFF = RING_BYTES + 320, LDS_BYTES = 147456;
constexpr int NPHASE = 11;
#ifndef MK_ONE_LAUNCH
#define MK_ONE_LAUNCH 1
#endif

typedef float f32x2v __attribute__((ext_vector_type(2)));
typedef unsigned u32x2v __attribute__((ext_vector_type(2)));

__device__ __forceinline__ float wave_sum(float v) {
#pragma unroll
    for (int o = 1; o < 64; o <<= 1) v += __shfl_xor(v, o);
    return v;
}
__device__ __forceinline__ unsigned cvtpk(float lo, float hi) { return pg8::cvt_pk_bf16(lo, hi); }
__device__ __forceinline__ float bflo(unsigned w) { return __builtin_bit_cast(float, w << 16); }
__device__ __forceinline__ float bfhi(unsigned w) { return __builtin_bit_cast(float, w & 0xffff0000u); }
__device__ __forceinline__ float bf1(unsigned short h) { return __builtin_bit_cast(float, (unsigned)h << 16); }

__device__ __forceinline__ int seq_rowbase(int s) { return s < 2 ? s * 4096 : 8192 + (s - 2) * 2048; }
__device__ __forceinline__ int seq_len(int s) { return s < 2 ? 4096 : 2048; }
__device__ __forceinline__ int seq_nchunks(int s) { return s < 2 ? 65 : 33; }
__device__ __forceinline__ int seq_chunkbase(int s) { return s < 2 ? s * 65 : 130 + (s - 2) * 33; }
__device__ __forceinline__ void cs_decode(int cs, int& s, int& c) { if (cs < 130) { s = cs >= 65 ? 1 : 0; c = cs - s * 65; } else { const int j = cs - 130; s = 2 + j / 33; c = j - (s - 2) * 33; } }
__device__ __forceinline__ int chunk_row(int s, int c, int i) { return c == 0 ? (i < 48 ? -1 : 16384 + 16 * s + (i - 48)) : seq_rowbase(s) + 64 * (c - 1) + i; }
__device__ __forceinline__ int pos_row(int s, int p) { return p < 16 ? 16384 + 16 * s + p : seq_rowbase(s) + p - 16; }

__device__ __forceinline__ void p0_item(const float* src, int N, bf16* dst, int K, LAS float* scr, int lane) {
    if (src) {
#pragma unroll 8
        for (int i = 0; i < 32; ++i) { const int kk = 2 * i + (lane >> 5); scr[kk * 33 + (lane & 31)] = src[(size_t)kk * N + (lane & 31)]; }
    } else {
#pragma unroll 8
        for (int i = 0; i < 32; ++i) { const int kk = 2 * i + (lane >> 5); scr[kk * 33 + (lane & 31)] = 0.f; }
    }
    LDS_WAIT(); asm volatile("" ::: "memory");
    const int c = lane & 7;
#pragma unroll
    for (int j = 0; j < 4; ++j) { const int n = (lane >> 3) + 8 * j; const LAS float* s = scr + (8 * c) * 33 + n;
        v4u o; o.x = pk2(s[0 * 33], s[1 * 33]); o.y = pk2(s[2 * 33], s[3 * 33]); o.z = pk2(s[4 * 33], s[5 * 33]); o.w = pk2(s[6 * 33], s[7 * 33]);
        *(GAS v4u*)(dst + (size_t)n * K + 8 * c) = o; }
    LDS_WAIT(); asm volatile("" ::: "memory");
}
template <bool OUT_BF16> __device__ __forceinline__ void norm_row(const float* xrow, const float* g, void* orow, int lane) {
    f32x4 v[16]; float s = 0.f;
#pragma unroll
    for (int j = 0; j < 8; ++j) { const GAS f32x4* p = (const GAS f32x4*)(xrow + 8 * lane + 512 * j); v[2 * j] = p[0]; v[2 * j + 1] = p[1]; }
#pragma unroll
    for (int j = 0; j < 16; ++j) s += (v[j].x * v[j].x + v[j].y * v[j].y) + (v[j].z * v[j].z + v[j].w * v[j].w);
    const float rstd = 1.0f / sqrtf(wave_sum(s) * (1.0f / 4096.0f) + EPS);
#pragma unroll
    for (int j = 0; j < 8; ++j) { const GAS f32x4* gp = (const GAS f32x4*)(g + 8 * lane + 512 * j); const f32x4 a = v[2 * j] * rstd * gp[0], b = v[2 * j + 1] * rstd * gp[1];
        if (OUT_BF16) { v4u o; o.x = cvtpk(a.x, a.y); o.y = cvtpk(a.z, a.w); o.z = cvtpk(b.x, b.y); o.w = cvtpk(b.z, b.w); *(GAS v4u*)((bf16*)orow + 8 * lane + 512 * j) = o; }
        else { GAS f32x4* op = (GAS f32x4*)((float*)orow + 8 * lane + 512 * j); op[0] = a; op[1] = b; } }
}

__device__ __forceinline__ float logsig16(float x) { return (fminf(x, 0.f) - log1pf(expf(-fabsf(x)))) * 0.0625f; }
__device__ __forceinline__ void prep_item(int it, LAS unsigned char* lds, const float* AD, const bf16* PQK, const float* wg2, const float* bg2, bf16* QT, bf16* KT, bf16* KH, float* ED, int tid, int wave, int lane) {
    const int cs = it >> 3, h = it & 7; int s, c; cs_decode(cs, s, c);
    LAS float* sA = (LAS float*)lds;
    LAS float* sT = (LAS float*)(lds + 8192);
    { const int i = tid >> 3, q4 = tid & 7; const int row = chunk_row(s, c, i);
      f32x4 a = (f32x4){0.f, 0.f, 0.f, 0.f}; if (row >= 0) a = *(const GAS f32x4*)(AD + (size_t)row * 32 + q4 * 4);
      *(LAS f32x4*)(sA + i * 32 + q4 * 4) = a; }
    __syncthreads();
    const int dp = lane, tg = wave;
    f32x2v wf[16], wb[16];
#pragma unroll
    for (int i = 0; i < 16; ++i) { wf[i] = *(const GAS f32x2v*)(wg2 + (size_t)i * 1024 + h * 128 + 2 * dp); wb[i] = *(const GAS f32x2v*)(wg2 + 16384 + (size_t)i * 1024 + h * 128 + 2 * dp); }
    const f32x2v bfw = *(const GAS f32x2v*)(bg2 + h * 128 + 2 * dp), bbw = *(const GAS f32x2v*)(bg2 + 1024 + h * 128 + 2 * dp);
    f32x2v lf[8], lb[8];
#pragma unroll
    for (int j = 0; j < 8; ++j) { const int i = 8 * tg + j; const bool padtok = (c == 0 && i < 48);
        f32x2v xf = bfw, xb = bbw;
#pragma unroll
        for (int k4 = 0; k4 < 4; ++k4) { const f32x4 a = *(const LAS f32x4*)(sA + i * 32 + 4 * k4), b = *(const LAS f32x4*)(sA + i * 32 + 16 + 4 * k4);
            xf += wf[4 * k4] * a.x + wf[4 * k4 + 1] * a.y + wf[4 * k4 + 2] * a.z + wf[4 * k4 + 3] * a.w;
            xb += wb[4 * k4] * b.x + wb[4 * k4 + 1] * b.y + wb[4 * k4 + 2] * b.z + wb[4 * k4 + 3] * b.w; }
        lf[j].x = padtok ? 0.f : logsig16(xf.x); lf[j].y = padtok ? 0.f : logsig16(xf.y);
        lb[j].x = padtok ? 0.f : logsig16(xb.x); lb[j].y = padtok ? 0.f : logsig16(xb.y); }
#pragma unroll
    for (int j = 1; j < 8; ++j) lf[j] += lf[j - 1];
#pragma unroll
    for (int j = 6; j >= 0; --j) lb[j] += lb[j + 1];
    *(LAS f32x2v*)(sT + tg * 128 + 2 * dp) = lf[7];
    *(LAS f32x2v*)(sT + 1024 + tg * 128 + 2 * dp) = lb[0];
    __syncthreads();
    f32x2v offf = (f32x2v){0.f, 0.f}, offb = offf, allf = offf, allb = offf;
#pragma unroll
    for (int g = 0; g < 8; ++g) { const f32x2v tf = *(const LAS f32x2v*)(sT + g * 128 + 2 * dp), tb = *(const LAS f32x2v*)(sT + 1024 + g * 128 + 2 * dp);
        allf += tf; allb += tb; if (g < tg) offf += tf; if (g > tg) offb += tb; }
    const size_t ib = (size_t)it * 8192, zb = (size_t)NITEM * 8192;
    bf16 *QTf = QT + ib, *QTb = QT + zb + ib, *KTf = KT + ib, *KTb = KT + zb + ib, *KHf = KH + ib, *KHb = KH + zb + ib;
    const float qs = 0.08838834764831845f;
    unsigned khf0[4], khf1[4], khb0[4], khb1[4];
    float pf0 = 0.f, pf1 = 0.f, pb0 = 0.f, pb1 = 0.f;
#pragma unroll
    for (int j = 0; j < 8; ++j) { const int i = 8 * tg + j; const int row = chunk_row(s, c, i);
        unsigned qw = 0u, kw = 0u; if (row >= 0) { qw = *(const GAS unsigned*)(PQK + (size_t)row * 2048 + h * 128 + 2 * dp); kw = *(const GAS unsigned*)(PQK + (size_t)row * 2048 + 1024 + h * 128 + 2 * dp); }
        const float q0 = bflo(qw) * qs, q1 = bfhi(qw) * qs, k0 = bflo(kw), k1 = bfhi(kw);
        const f32x2v Bp = offf + lf[j], Bs = offb + lb[j];
        const float ef0 = expf(Bp.x), ef1 = expf(Bp.y), eb0 = expf(Bs.x), eb1 = expf(Bs.y);
        *(GAS unsigned*)(QTf + i * 128 + 2 * dp) = cvtpk(q0 * ef0, q1 * ef1);
        *(GAS unsigned*)(QTb + i * 128 + 2 * dp) = cvtpk(q0 * eb0, q1 * eb1);
        *(GAS unsigned*)(KTf + i * 128 + 2 * dp) = cvtpk(k0 * expf(-Bp.x), k1 * expf(-Bp.y));
        *(GAS unsigned*)(KTb + i * 128 + 2 * dp) = cvtpk(k0 * expf(-Bs.x), k1 * expf(-Bs.y));
        const float hf0 = k0 * expf(allf.x - Bp.x), hf1 = k1 * expf(allf.y - Bp.y), hb0 = k0 * expf(allb.x - Bs.x), hb1 = k1 * expf(allb.y - Bs.y);
        if (j & 1) { khf0[j >> 1] = cvtpk(pf0, hf0); khf1[j >> 1] = cvtpk(pf1, hf1); khb0[j >> 1] = cvtpk(pb0, hb0); khb1[j >> 1] = cvtpk(pb1, hb1); }
        else { pf0 = hf0; pf1 = hf1; pb0 = hb0; pb1 = hb1; } }
    *(GAS v4u*)(KHf + (size_t)(2 * dp) * 64 + 8 * tg) = (v4u){khf0[0], khf0[1], khf0[2], khf0[3]};
    *(GAS v4u*)(KHf + (size_t)(2 * dp + 1) * 64 + 8 * tg) = (v4u){khf1[0], khf1[1], khf1[2], khf1[3]};
    *(GAS v4u*)(KHb + (size_t)(2 * dp) * 64 + 8 * tg) = (v4u){khb0[0], khb0[1], khb0[2], khb0[3]};
    *(GAS v4u*)(KHb + (size_t)(2 * dp + 1) * 64 + 8 * tg) = (v4u){khb1[0], khb1[1], khb1[2], khb1[3]};
    if (tg == 0) { *(GAS f32x2v*)(ED + (size_t)it * 128 + 2 * dp) = (f32x2v){expf(allf.x), expf(allf.y)};
                   *(GAS f32x2v*)(ED + (size_t)(NITEM + it) * 128 + 2 * dp) = (f32x2v){expf(allb.x), expf(allb.y)}; }
    __syncthreads();
}
__device__ __forceinline__ void load_m8(const bf16* PC, int row, int ch0, float (&m)[8]) {
    const v4u a = *(const GAS v4u*)(PC + (size_t)row * 6144 + 2048 + ch0), b = *(const GAS v4u*)(PC + (size_t)row * 6144 + 4096 + ch0);
    m[0] = bflo(a.x) * bflo(b.x); m[1] = bfhi(a.x) * bfhi(b.x); m[2] = bflo(a.y) * bflo(b.y); m[3] = bfhi(a.y) * bfhi(b.y);
    m[4] = bflo(a.z) * bflo(b.z); m[5] = bfhi(a.z) * bfhi(b.z); m[6] = bflo(a.w) * bflo(b.w); m[7] = bfhi(a.w) * bfhi(b.w);
}
__device__ __forceinline__ void conv_item(int cs, const bf16* PC, const float* cw, bf16* MIX, int tid) {
    int s, blk; cs_decode(cs, s, blk);
    const int np = seq_len(s) + 16, ch0 = 8 * (tid & 255), pstart = 64 * blk + 32 * (tid >> 8);
    if (pstart < np) {
        float w0[8], w1[8], w2[8];
#pragma unroll
        for (int e = 0; e < 8; ++e) { w0[e] = cw[ch0 + e]; w1[e] = cw[2048 + ch0 + e]; w2[e] = cw[4096 + ch0 + e]; }
        float mp[8], mc[8], mn[8];
#pragma unroll
        for (int e = 0; e < 8; ++e) mp[e] = 0.f;
        if (pstart > 0) load_m8(PC, pos_row(s, pstart - 1), ch0, mp);
        load_m8(PC, pos_row(s, pstart), ch0, mc);
        for (int j = 0; j < 32; ++j) { const int p = pstart + j; if (p >= np) break;
#pragma unroll
            for (int e = 0; e < 8; ++e) mn[e] = 0.f;
            if (p + 1 < np) load_m8(PC, pos_row(s, p + 1), ch0, mn);
            const int row = pos_row(s, p);
            const v4u cbw = *(const GAS v4u*)(PC + (size_t)row * 6144 + ch0);
            float o[8]; const float cbv[8] = {bflo(cbw.x), bfhi(cbw.x), bflo(cbw.y), bfhi(cbw.y), bflo(cbw.z), bfhi(cbw.z), bflo(cbw.w), bfhi(cbw.w)};
#pragma unroll
            for (int e = 0; e < 8; ++e) { o[e] = cbv[e] * (w0[e] * mp[e] + w1[e] * mc[e] + w2[e] * mn[e]); mp[e] = mc[e]; mc[e] = mn[e]; }
            v4u ow; ow.x = cvtpk(o[0], o[1]); ow.y = cvtpk(o[2], o[3]); ow.z = cvtpk(o[4], o[5]); ow.w = cvtpk(o[6], o[7]);
            *(GAS v4u*)(MIX + (size_t)row * 4096 + 2048 + ch0) = ow; }
    }
}

constexpr int SC_BUF = 51712, SC_KT = 16384, SC_KH = 32768, SC_ED = 51200, SC_P = 2 * SC_BUF;
__device__ __forceinline__ bf16x8 mk8(unsigned a, unsigned b, unsigned c, unsigned d) { const v4u t = (v4u){a, b, c, d}; return __builtin_bit_cast(bf16x8, t); }
__device__ __forceinline__ void scan_item(int idx, LAS unsigned char* lds, const bf16* QT, const bf16* KT, const bf16* KH, const float* ED, const bf16* PV, bf16* O2, int tid, int wave, int lane) {
    int s, rem; if (idx < 64) { s = idx >> 5; rem = idx & 31; } else { s = 2 + ((idx - 64) >> 5); rem = (idx - 64) & 31; }
    const int h = rem >> 2, z = (rem >> 1) & 1, vh = rem & 1;
    const int nc = seq_nchunks(s), cbase = seq_chunkbase(s);
    const int fr = lane & 15, fq = lane >> 4;
    const int vcol = h * 256 + vh * 128 + 16 * wave + fr;
    f32x4 Sacc[8];
#pragma unroll
    for (int i = 0; i < 8; ++i) Sacc[i] = (f32x4){0.f, 0.f, 0.f, 0.f};
    v4u stq[2], stk[2], sth[2]; f32x4 sted = (f32x4){0.f, 0.f, 0.f, 0.f}; unsigned short vr[16];
    bf16x8 vcur[2];
#define SC_LOAD(c_) do { const int it_ = (cbase + (c_)) * 8 + h; const size_t ib_ = ((size_t)z * NITEM + it_) * 8192; \
        _Pragma("unroll") for (int i_ = 0; i_ < 2; ++i_) { stq[i_] = ((const GAS v4u*)(QT + ib_))[tid + 512 * i_]; stk[i_] = ((const GAS v4u*)(KT + ib_))[tid + 512 * i_]; sth[i_] = ((const GAS v4u*)(KH + ib_))[tid + 512 * i_]; } \
        if (tid < 32) sted = ((const GAS f32x4*)(ED + ((size_t)z * NITEM + it_) * 128))[tid]; \
        _Pragma("unroll") for (int e_ = 0; e_ < 16; ++e_) { const int i_ = 32 * (e_ >> 3) + 8 * fq + (e_ & 7); const int row_ = chunk_row(s, (c_), i_); vr[e_] = row_ >= 0 ? PV[(size_t)row_ * 2048 + vcol] : (unsigned short)0; } } while (0)
#define SC_WRITE(b_) do { LAS unsigned char* bb_ = lds + (b_) * SC_BUF; \
        _Pragma("unroll") for (int i_ = 0; i_ < 2; ++i_) { const int q_ = tid + 512 * i_; const int r_ = q_ >> 4, c_ = q_ & 15; const int o_ = r_ * 256 + ((c_ ^ (r_ & 15)) << 4); \
            *(LAS v4u*)(bb_ + o_) = stq[i_]; *(LAS v4u*)(bb_ + SC_KT + o_) = stk[i_]; *(LAS v4u*)(bb_ + SC_KH + (q_ >> 3) * 144 + (q_ & 7) * 16) = sth[i_]; } \
        if (tid < 32) *(LAS f32x4*)(bb_ + SC_ED + tid * 16) = sted; \
        vcur[0] = mk8((unsigned)vr[0] | ((unsigned)vr[1] << 16), (unsigned)vr[2] | ((unsigned)vr[3] << 16), (unsigned)vr[4] | ((unsigned)vr[5] << 16), (unsigned)vr[6] | ((unsigned)vr[7] << 16)); \
        vcur[1] = mk8((unsigned)vr[8] | ((unsigned)vr[9] << 16), (unsigned)vr[10] | ((unsigned)vr[11] << 16), (unsigned)vr[12] | ((unsigned)vr[13] << 16), (unsigned)vr[14] | ((unsigned)vr[15] << 16)); } while (0)
    { const int c0 = z ? nc - 1 : 0; SC_LOAD(c0); SC_WRITE(0); }
    __syncthreads();
    for (int step = 0; step < nc; ++step) {
        const int c = z ? nc - 1 - step : step; const int b = step & 1;
        LAS unsigned char* QTb = lds + b * SC_BUF; LAS unsigned char* KTb = QTb + SC_KT; LAS unsigned char* KHb = QTb + SC_KH; LAS unsigned char* EDb = QTb + SC_ED; LAS unsigned char* Pb = lds + SC_P;
        const bool more = step + 1 < nc;
        if (more) { const int cn = z ? nc - 2 - step : step + 1; SC_LOAD(cn); }
#pragma unroll
        for (int e2 = 0; e2 < 2; ++e2) { const int e = 2 * wave + e2, si = e >> 2, ti = e & 3;
            f32x4 a4 = (f32x4){0.f, 0.f, 0.f, 0.f};
#pragma unroll
            for (int kk = 0; kk < 4; ++kk) { const int off = (((4 * kk + fq) ^ fr) << 4);
                const bf16x8 A = *(const LAS bf16x8*)(KTb + (16 * si + fr) * 256 + off), B = *(const LAS bf16x8*)(QTb + (16 * ti + fr) * 256 + off);
                a4 = __builtin_amdgcn_mfma_f32_16x16x32_bf16(A, B, a4, 0, 0, 0); }
            const int tg_ = 16 * ti + fr, sg0 = 16 * si + 4 * fq;
            float p[4];
#pragma unroll
            for (int r = 0; r < 4; ++r) { const int sg = sg0 + r; const bool keep = z ? (sg > tg_) : (sg <= tg_); p[r] = keep ? a4[r] : 0.f; }
            *(LAS u32x2v*)(Pb + tg_ * 144 + sg0 * 2) = (u32x2v){cvtpk(p[0], p[1]), cvtpk(p[2], p[3])}; }
        f32x4 oacc[4];
        { bf16x8 Sb[4];
#pragma unroll
          for (int kk = 0; kk < 4; ++kk) Sb[kk] = mk8(cvtpk(Sacc[2 * kk][0], Sacc[2 * kk][1]), cvtpk(Sacc[2 * kk][2], Sacc[2 * kk][3]), cvtpk(Sacc[2 * kk + 1][0], Sacc[2 * kk + 1][1]), cvtpk(Sacc[2 * kk + 1][2], Sacc[2 * kk + 1][3]));
#pragma unroll
          for (int ti = 0; ti < 4; ++ti) { oacc[ti] = (f32x4){0.f, 0.f, 0.f, 0.f};
#pragma unroll
            for (int kk = 0; kk < 4; ++kk) { const LAS unsigned char* rp = QTb + (16 * ti + fr) * 256 + (fq & 1) * 8;
                const u32x2v lo = *(const LAS u32x2v*)(rp + (((4 * kk + (fq >> 1)) ^ fr) << 4)), hi = *(const LAS u32x2v*)(rp + (((4 * kk + 2 + (fq >> 1)) ^ fr) << 4));
                oacc[ti] = __builtin_amdgcn_mfma_f32_16x16x32_bf16(mk8(lo.x, lo.y, hi.x, hi.y), Sb[kk], oacc[ti], 0, 0, 0); } } }
        __syncthreads();
#pragma unroll
        for (int ti = 0; ti < 4; ++ti)
#pragma unroll
            for (int kk = 0; kk < 2; ++kk) { const bf16x8 A = *(const LAS bf16x8*)(Pb + (16 * ti + fr) * 144 + (32 * kk + 8 * fq) * 2);
                oacc[ti] = __builtin_amdgcn_mfma_f32_16x16x32_bf16(A, vcur[kk], oacc[ti], 0, 0, 0); }
#pragma unroll
        for (int ti = 0; ti < 4; ++ti)
#pragma unroll
            for (int r = 0; r < 4; ++r) { const int row = chunk_row(s, c, 16 * ti + 4 * fq + r);
                if (row >= 0) O2[((size_t)z * MP + row) * 2048 + vcol] = (unsigned short)(cvtpk(oacc[ti][r], 0.f) & 0xffffu); }
#pragma unroll
        for (int i8 = 0; i8 < 8; ++i8) { const f32x4 ed4 = *(const LAS f32x4*)(EDb + (16 * i8 + 4 * fq) * 4); Sacc[i8] = Sacc[i8] * ed4;
#pragma unroll
            for (int kk = 0; kk < 2; ++kk) { const bf16x8 A = *(const LAS bf16x8*)(KHb + (16 * i8 + fr) * 144 + (32 * kk + 8 * fq) * 2);
                Sacc[i8] = __builtin_amdgcn_mfma_f32_16x16x32_bf16(A, vcur[kk], Sacc[i8], 0, 0, 0); } }
        if (more) SC_WRITE(b ^ 1);
        __syncthreads();
    }
#undef SC_LOAD
#undef SC_WRITE
}

__device__ __forceinline__ void ldbf8(const bf16* p, float (&o)[8]) { const v4u a = *(const GAS v4u*)p; o[0] = bflo(a.x); o[1] = bfhi(a.x); o[2] = bflo(a.y); o[3] = bfhi(a.y); o[4] = bflo(a.z); o[5] = bfhi(a.z); o[6] = bflo(a.w); o[7] = bfhi(a.w); }
__device__ __forceinline__ void ffn_item(int item, const bf16* UG, const float* fw, const float* fb, bf16* H, int tid) {
    const int blk = item / 6, part = item - blk * 6;
    int s, tb; if (blk < 128) { s = blk >> 6; tb = blk & 63; } else { s = 2 + ((blk - 128) >> 5); tb = (blk - 128) & 31; }
    const int cg = part * 256 + (tid & 255);
    if (cg < 1376) {
        const int ch0 = 8 * cg, L = seq_len(s), rb = seq_rowbase(s), t0 = 64 * tb + 32 * (tid >> 8);
        float w0[8], w1[8], w2[8], bb[8];
#pragma unroll
        for (int e = 0; e < 8; ++e) { w0[e] = fw[ch0 + e]; w1[e] = fw[DFF + ch0 + e]; w2[e] = fw[2 * DFF + ch0 + e]; bb[e] = fb[ch0 + e]; }
        float gp[8], gc[8], gn[8];
        ldbf8(UG + (size_t)(t0 > 0 ? rb + t0 - 1 : 16384 + 16 * s + 15) * NUP + DFF + ch0, gp);
        ldbf8(UG + (size_t)(rb + t0) * NUP + DFF + ch0, gc);
        for (int j = 0; j < 32; ++j) { const int t = t0 + j;
#pragma unroll
            for (int e = 0; e < 8; ++e) gn[e] = 0.f;
            if (t + 1 < L) ldbf8(UG + (size_t)(rb + t + 1) * NUP + DFF + ch0, gn);
            float u[8]; ldbf8(UG + (size_t)(rb + t) * NUP + ch0, u);
            float o[8];
#pragma unroll
            for (int e = 0; e < 8; ++e) { const float gg = w0[e] * gp[e] + w1[e] * gc[e] + w2[e] * gn[e] + bb[e]; o[e] = gg / (1.0f + expf(-gg)) * u[e]; gp[e] = gc[e]; gc[e] = gn[e]; }
            v4u ow; ow.x = cvtpk(o[0], o[1]); ow.y = cvtpk(o[2], o[3]); ow.z = cvtpk(o[4], o[5]); ow.w = cvtpk(o[6], o[7]);
            *(GAS v4u*)(H + (size_t)(rb + t) * DFF + ch0) = ow; }
    }
}

struct Args { const float* in[16]; float* out; unsigned char* ws; int ph_lo, ph_hi; };
__global__ void __launch_bounds__(NWAVES * 64, 2) fwd(Args args) {
    extern __shared__ __attribute__((aligned(16))) unsigned char lds_raw[];
    LAS unsigned char* lds = (LAS unsigned char*)lds_raw;
    volatile LAS unsigned* MISC = (volatile LAS unsigned*)(lds + MISC_OFF);
    const int tid = threadIdx.x, lane = tid & 63, wave = __builtin_amdgcn_readfirstlane(tid >> 6);
    const int G = gridDim.x, bid = blockIdx.x;
    const int gw = bid * NWAVES + wave, NGW = G * NWAVES;
    unsigned char* ws = args.ws;
    gu32* ctl = (gu32*)(ws + WS_CTL);
    const float *x_prompt = args.in[0], *x_sample = args.in[1], *meta = args.in[2], *mix_g = args.in[3], *w_in = args.in[4], *wg2 = args.in[5], *bg2 = args.in[6], *hng = args.in[7],
                *cmw = args.in[8], *w_out = args.in[9], *ffn_g = args.in[10], *w_up = args.in[11], *fcw = args.in[12], *fcb = args.in[13], *w_down = args.in[14], *fin_g = args.in[15];
    float* out = args.out;
    float* AD = (float*)(ws + WS_AD); float* X1M = (float*)(ws + WS_X1M);
    bf16 *WD = (bf16*)(ws + WS_WD), *WI = (bf16*)(ws + WS_WI), *WO = (bf16*)(ws + WS_WO), *WU = (bf16*)(ws + WS_WU), *XN = (bf16*)(ws + WS_XN);
    bf16 *PQK = (bf16*)(ws + WS_PQK), *PC = (bf16*)(ws + WS_PC), *PV = (bf16*)(ws + WS_PV), *PR = (bf16*)(ws + WS_PR);
    bf16 *QT = (bf16*)(ws + WS_QT), *KT = (bf16*)(ws + WS_KT), *KH = (bf16*)(ws + WS_KH); float* ED = (float*)(ws + WS_ED);
    bf16 *MIX = (bf16*)(ws + WS_MIX), *O2 = (bf16*)(ws + WS_O2), *UG = (bf16*)(ws + WS_UG), *HB = (bf16*)(ws + WS_H);

    for (int u = tid; u < (LDS_BYTES - RING_BYTES) / 4; u += NWAVES * 64) ((LAS unsigned*)(lds + RING_BYTES))[u] = 0u;
    __syncthreads();
    const int lo = args.ph_lo, hi = args.ph_hi;
    const bool use_bar = (hi - lo) > 1;
    XcdBarrier bar; bar.bar = (unsigned*)(ctl + CW_BAR); bar.x = 0; bar.st = nullptr;
    if (use_bar) bar = xcd_barrier_post((unsigned*)(ctl + CW_BAR), MISC + 8);
#define IN(k) (lo <= (k) && (k) < hi)
#define SEAM(k) do { if (IN(k) && IN((k) + 1)) xcd_barrier(bar); } while (0)

    if (IN(0)) {
        LAS float* scr = (LAS float*)(lds + wave * 16384);
        constexpr int NB_I = NI / 32, NB_O = DM / 32, NB_U = NUP / 32, NB_D = DM / 32;
        constexpr int I_I = (DM / 64) * NB_I, I_O = (DM / 64) * NB_O, I_U = (DM / 64) * NB_U, I_D = (DFF / 64) * NB_D;
        for (int it = gw; it < I_I + I_O + I_U + I_D; it += NGW) {
            int r = it;
            if (r < I_I) { const int kb = r / NB_I, nb = r - kb * NB_I; const int n0 = 32 * nb;
                const int srcn = n0 < 6144 ? n0 : (n0 < 12288 ? n0 + 32 : (n0 == 12288 ? 6144 : -1));
                p0_item(srcn >= 0 ? w_in + (size_t)(64 * kb) * 12320 + srcn : nullptr, 12320, WI + (size_t)n0 * DM + 64 * kb, DM, scr, lane); continue; }
            r -= I_I;
            if (r < I_O) { const int kb = r / NB_O, nb = r - kb * NB_O; p0_item(w_out + (size_t)(64 * kb) * DM + 32 * nb, DM, WO + (size_t)(32 * nb) * DM + 64 * kb, DM, scr, lane); continue; }
            r -= I_O;
            if (r < I_U) { const int kb = r / NB_U, nb = r - kb * NB_U; p0_item(w_up + (size_t)(64 * kb) * NUP + 32 * nb, NUP, WU + (size_t)(32 * nb) * DM + 64 * kb, DM, scr, lane); continue; }
            r -= I_U;
            { const int kb = r / NB_D, nb = r - kb * NB_D; p0_item(w_down + (size_t)(64 * kb) * DM + 32 * nb, DM, WD + (size_t)(32 * nb) * DFF + 64 * kb, DFF, scr, lane); }
        }
        for (int m = gw; m < MP; m += NGW) {
            if (m < MTOK) { const float* xr = m < 8192 ? x_prompt + (size_t)m * DM : (m < 16384 ? x_sample + (size_t)(m - 8192) * DM : meta + (size_t)((m - 16384) & 15) * DM);
                norm_row<true>(xr, mix_g, XN + (size_t)m * DM, lane); }
            else { GAS v4u* o = (GAS v4u*)(XN + (size_t)m * DM) + lane;
#pragma unroll
                for (int j = 0; j < 8; ++j) o[64 * j] = (v4u){0u, 0u, 0u, 0u}; }
        }
    }
    SEAM(0);
    if (IN(1)) {
        pg8::Gemm g{XN, WI, MP, NI, DM}; pg8::StaticOrder S; S.init(MP, NI, G, bid);
        pg8::EpiIn E{PQK, PV, PR, PC, AD};
        pg8::gemm_phase<pg8::EpiIn, pg8::StaticOrder, true, true>(lds, g, S, E);
    }
    SEAM(1);
    if (IN(2)) {
        for (int it = bid; it < NITEM + NCSEQ; it += G) {
            if (it < NITEM) prep_item(it, lds, AD, PQK, wg2, bg2, QT, KT, KH, ED, tid, wave, lane);
            else conv_item(it - NITEM, PC, cmw, MIX, tid);
        }
    }
    SEAM(2);
    if (IN(3)) {
        for (int it = bid; it < 192; it += G) scan_item(it, lds, QT, KT, KH, ED, PV, O2, tid, wave, lane);
    }
    SEAM(3);
    if (IN(4)) {
        const f32x4 g4 = *(const GAS f32x4*)(hng + 4 * lane);
        for (int wi = gw; wi < MTOK * 8; wi += NGW) { const int row = wi >> 3, h = wi & 7;
            const u32x2v a = *(const GAS u32x2v*)(O2 + (size_t)row * 2048 + h * 256 + 4 * lane), b = *(const GAS u32x2v*)(O2 + ((size_t)MP + row) * 2048 + h * 256 + 4 * lane);
            const u32x2v rw = *(const GAS u32x2v*)(PR + (size_t)row * 2048 + h * 256 + 4 * lane);
            const float o0 = bflo(a.x) + bflo(b.x), o1 = bfhi(a.x) + bfhi(b.x), o2 = bflo(a.y) + bflo(b.y), o3 = bfhi(a.y) + bfhi(b.y);
            const float rs = 1.0f / sqrtf(wave_sum((o0 * o0 + o1 * o1) + (o2 * o2 + o3 * o3)) * (1.0f / 256.0f) + EPS);
            const float r0 = bflo(rw.x), r1 = bfhi(rw.x), r2 = bflo(rw.y), r3 = bfhi(rw.y);
            const float y0 = o0 * rs * g4.x * (r0 / (1.0f + expf(-r0))), y1 = o1 * rs * g4.y * (r1 / (1.0f + expf(-r1))), y2 = o2 * rs * g4.z * (r2 / (1.0f + expf(-r2))), y3 = o3 * rs * g4.w * (r3 / (1.0f + expf(-r3)));
            *(GAS u32x2v*)(MIX + (size_t)row * 4096 + h * 256 + 4 * lane) = (u32x2v){cvtpk(y0, y1), cvtpk(y2, y3)}; }
    }
    SEAM(4);
    if (IN(5)) {
        pg8::Gemm g{MIX, WO, MP, DM, DM}; pg8::StaticOrder S; S.init(MP, DM, G, bid);
        pg8::EpiOut E{x_prompt, x_sample, meta, out, X1M};
        pg8::gemm_phase<pg8::EpiOut, pg8::StaticOrder, true, true>(lds, g, S, E);
    }
    SEAM(5);
    if (IN(6)) {
        for (int m = gw; m < MTOK; m += NGW) norm_row<true>(m < MREAL ? out + (size_t)m * DM : X1M + (size_t)(m - MREAL) * DM, ffn_g, XN + (size_t)m * DM, lane);
    }
    SEAM(6);
    if (IN(7)) {
        pg8::Gemm g{XN, WU, MP, NUP, DM}; pg8::StaticOrder S; S.init(MP, NUP, G, bid);
        pg8::EpiBf16Plain E{UG, NUP};
        pg8::gemm_phase<pg8::EpiBf16Plain, pg8::StaticOrder, true, true>(lds, g, S, E);
    }
    SEAM(7);
    if (IN(8)) {
        for (int it = bid; it < 256 * 6; it += G) ffn_item(it, UG, fcw, fcb, HB, tid);
    }
    SEAM(8);
    if (IN(9)) {
        pg8::Gemm g{HB, WD, MREAL, DM, DFF}; pg8::StaticOrder S; S.init(MREAL, DM, G, bid);
        pg8::EpiDown E{out};
        pg8::gemm_phase<pg8::EpiDown, pg8::StaticOrder, true, true>(lds, g, S, E);
    }
    SEAM(9);
    if (IN(10)) {
        for (int m = gw; m < MREAL; m += NGW) norm_row<false>(out + (size_t)m * DM, fin_g, out + (size_t)m * DM, lane);
    }
#undef IN
#undef SEAM
}

extern "C" void kernel_launch(void* const* d_in, const int* in_sizes, int n_in, void* d_out, int out_size, void* d_ws, size_t ws_size, hipStream_t stream) {
    static int grid = 0;
    if (grid == 0) {
        if (n_in != 16 || ws_size < WS_END) { fprintf(stderr, "kernel_launch: unexpected n_in %d / ws_size %zu (need %zu)\n", n_in, ws_size, (size_t)WS_END); grid = -1; return; }
        int dev = 0, cus = 0, per_cu = 0;
        if (hipGetDevice(&dev) != hipSuccess || hipDeviceGetAttribute(&cus, hipDeviceAttributeMultiprocessorCount, dev) != hipSuccess) { grid = -1; return; }
        if (hipFuncSetAttribute((const void*)fwd, hipFuncAttributeMaxDynamicSharedMemorySize, LDS_BYTES) != hipSuccess) { fprintf(stderr, "kernel_launch: hipFuncSetAttribute failed\n"); grid = -1; return; }
        if (hipOccupancyMaxActiveBlocksPerMultiprocessor(&per_cu, (const void*)fwd, NWAVES * 64, LDS_BYTES) != hipSuccess || per_cu < 1) { fprintf(stderr, "kernel_launch: occupancy query says %d\n", per_cu); }
        (void)hipGetLastError();
        grid = cus;
    }
    if (grid < 0) return;
    (void)hipMemsetAsync((char*)d_ws + WS_CTL, 0, CTL_ZERO_BYTES, stream);
    Args a{};
    for (int i = 0; i < 16; ++i) a.in[i] = (const float*)d_in[i];
    a.out = (float*)d_out; a.ws = (unsigned char*)d_ws;
#if MK_ONE_LAUNCH
    a.ph_lo = 0; a.ph_hi = NPHASE;
    hipLaunchKernelGGL(fwd, dim3(grid), dim3(NWAVES * 64), LDS_BYTES, stream, a);
#else
    for (int p = 0; p < NPHASE; ++p) { a.ph_lo = p; a.ph_hi = p + 1; hipLaunchKernelGGL(fwd, dim3(grid), dim3(NWAVES * 64), LDS_BYTES, stream, a); }
#endif
}
```

```cpp
#include <hip/hip_runtime.h>
#include <cstdio>
#include <cstdint>
namespace pg8 {
#define PG8_LAS __attribute__((address_space(3)))
typedef unsigned short bf16_t;
typedef short bf16x8 __attribute__((ext_vector_type(8)));
typedef float f32x4 __attribute__((ext_vector_type(4)));
typedef unsigned u32x4 __attribute__((ext_vector_type(4)));
typedef unsigned u32x2 __attribute__((ext_vector_type(2)));
typedef int i32x4 __attribute__((ext_vector_type(4)));
constexpr int BM = 256, BK = 64, HALF = 128, HTB = HALF * BK * 2  , STAGE_BYTES = 8 * HTB, NXCD = 8, WGM = 8;

__host__ __device__ __forceinline__ int lds_byte(int r, int c) { const int st = (r >> 4) * 2 + (c >> 5), rr = r & 15, cc = c & 31, ob = rr * 64 + cc * 2; return st * 1024 + (ob ^ (((ob >> 9) & 1) << 5)); }
__host__ __device__ __forceinline__ void stage_rc(int b, int& R, int& C) { const int st = b / 1024, sb = b % 1024, swz = sb ^ (((sb >> 9) & 1) << 5); R = (st >> 1) * 16 + swz / 64; C = (st & 1) * 32 + (swz % 64) / 2; }
__host__ __device__ __forceinline__ int perm32(int rho) { const int n = rho >> 4, i = rho & 15; return 8 * (i >> 2) + 4 * n + (i & 3); }

struct Unit { int pm, pn; int ks = 0; };
struct Gemm { const bf16_t* A; const bf16_t* Bt; int M, N, K; int ld = 0; };

struct StaticOrder {
    int nM, nN, nwg, G, c;
    __host__ __device__ void init(int M, int N, int G_, int c_) { nM = M / BM; nN = N / BM; nwg = nM * nN; G = G_; c = c_; }
    __host__ __device__ bool next(int i, Unit& u) const {
        const long L = (long)i * G + c; if (L >= nwg) return false;
        int wgid = (int)L; { const int q = nwg / NXCD, r = nwg % NXCD, xcd = wgid % NXCD, off = wgid / NXCD; wgid = (xcd < r ? xcd * (q + 1) : r * (q + 1) + (xcd - r) * q) + off; }
        const int nig = WGM * nN, gid = wgid / nig, fm = gid * WGM, gsz = (nM - fm) < WGM ? (nM - fm) : WGM;
        u.pm = fm + ((wgid % nig) % gsz); u.pn = (wgid % nig) / gsz; return true;
    }
    __device__ __forceinline__ void a_ready(const Unit&) const {}
    __device__ __forceinline__ void done(const Unit&) const {}
};

typedef float f32x2_t __attribute__((ext_vector_type(2))); typedef __bf16 bf16x2_t __attribute__((ext_vector_type(2)));
__device__ __forceinline__ unsigned cvt_pk_bf16(float lo, float hi) { const f32x2_t v = {lo, hi}; const bf16x2_t b = __builtin_convertvector(v, bf16x2_t); return __builtin_bit_cast(unsigned, b); }
typedef float f32x2 __attribute__((ext_vector_type(2)));
struct EpiIn {
    static constexpr bool PERM = true, AFTER_DRAIN = false;
    bf16_t *PQK, *PV, *PR, *PC; float* AD; int pn_off;
    __device__ __forceinline__ void operator()(const f32x4 (&acc)[2][2][4][2], const Unit& u, int wr, int wc, int fr, int fq) const {
        const int row0 = u.pm * BM + wr * 64 + fr; const int pn = u.pn + pn_off;
        if (pn < 32) {
            bf16_t* base; int ldc, colt;
            if (pn < 8) { base = PV; ldc = 2048; colt = pn * 256; }
            else if (pn < 16) { base = PR; ldc = 2048; colt = (pn - 8) * 256; }
            else if (pn < 24) { base = PQK; ldc = 2048; colt = (pn - 16) * 256; }
            else { base = PC; ldc = 4096; colt = (pn - 24) * 256; }
            const int col0 = colt + wc * 32 + 8 * fq;
#pragma unroll
            for (int ai = 0; ai < 2; ++ai)
#pragma unroll
                for (int m = 0; m < 4; ++m) { bf16_t* rowp = base + (size_t)(row0 + ai * HALF + m * 16) * ldc + col0;
#pragma unroll
                    for (int bj = 0; bj < 2; ++bj) { const f32x4 v0 = acc[ai][bj][m][0], v1 = acc[ai][bj][m][1];
                        u32x4 w; w.x = cvt_pk_bf16(v0[0], v0[1]); w.y = cvt_pk_bf16(v0[2], v0[3]); w.z = cvt_pk_bf16(v1[0], v1[1]); w.w = cvt_pk_bf16(v1[2], v1[3]);
                        *(u32x4*)(rowp + bj * HALF) = w; } }
        } else if (pn < 48) {
            const int col0 = 2048 + (pn - 32) * 128 + wc * 32 + 8 * fq;
#pragma unroll
            for (int ai = 0; ai < 2; ++ai)
#pragma unroll
                for (int m = 0; m < 4; ++m) { bf16_t* rowp = PC + (size_t)(row0 + ai * HALF + m * 16) * 4096 + col0;
                    const f32x4 v0 = acc[ai][0][m][0] * acc[ai][1][m][0], v1 = acc[ai][0][m][1] * acc[ai][1][m][1];
                    u32x4 w; w.x = cvt_pk_bf16(v0[0], v0[1]); w.y = cvt_pk_bf16(v0[2], v0[3]); w.z = cvt_pk_bf16(v1[0], v1[1]); w.w = cvt_pk_bf16(v1[2], v1[3]);
                    *(u32x4*)rowp = w; }
        } else if (wc == 0) {
#pragma unroll
            for (int ai = 0; ai < 2; ++ai)
#pragma unroll
                for (int m = 0; m < 4; ++m) { float* rowp = AD + (size_t)(row0 + ai * HALF + m * 16) * 32 + 8 * fq;
#pragma unroll
                    for (int n = 0; n < 2; ++n) *(f32x4*)(rowp + 4 * n) = acc[ai][0][m][n]; }
        }
    }
};
struct EpiIn8 {
    static constexpr bool PERM = true, AFTER_DRAIN = false;
    bf16_t *PQK, *PV, *PR; const float* RF; const float* CM;
    __device__ __forceinline__ void operator()(const f32x4 (&acc)[2][2][4][2], const Unit& u, int wr, int wc, int fr, int fq) const {
        const int row0 = u.pm * BM + wr * 64 + fr; const int pn = u.pn;
        bf16_t* base; int colt;
        if (pn < 8) { base = PV; colt = pn * 256; } else if (pn < 16) { base = PR; colt = (pn - 8) * 256; } else { base = PQK; colt = (pn - 16) * 256; }
        const int col0 = colt + wc * 32 + 8 * fq;
        f32x4 cf[2][2];
#pragma unroll
        for (int bj = 0; bj < 2; ++bj)
#pragma unroll
            for (int n = 0; n < 2; ++n) cf[bj][n] = *(const f32x4*)(CM + pn * 256 + bj * HALF + wc * 32 + 8 * fq + 4 * n) * (1.0f / 127.0f);
#pragma unroll
        for (int ai = 0; ai < 2; ++ai)
#pragma unroll
            for (int m = 0; m < 4; ++m) { const int row = row0 + ai * HALF + m * 16; const float rf = RF[row]; bf16_t* rowp = base + (size_t)row * 2048 + col0;
#pragma unroll
                for (int bj = 0; bj < 2; ++bj) { const f32x4 v0 = __builtin_convertvector(__builtin_bit_cast(i32x4, acc[ai][bj][m][0]), f32x4) * (cf[bj][0] * rf), v1 = __builtin_convertvector(__builtin_bit_cast(i32x4, acc[ai][bj][m][1]), f32x4) * (cf[bj][1] * rf);
                    u32x4 w; w.x = cvt_pk_bf16(v0[0], v0[1]); w.y = cvt_pk_bf16(v0[2], v0[3]); w.z = cvt_pk_bf16(v1[0], v1[1]); w.w = cvt_pk_bf16(v1[2], v1[3]);
                    *(u32x4*)(rowp + bj * HALF) = w; } }
    }
};
struct EpiBf16Plain {
    static constexpr bool PERM = true, AFTER_DRAIN = false;
    bf16_t* O; int ldc;
    __device__ __forceinline__ void operator()(const f32x4 (&acc)[2][2][4][2], const Unit& u, int wr, int wc, int fr, int fq) const {
        const int row0 = u.pm * BM + wr * 64 + fr, col0 = u.pn * BM + wc * 32 + 8 * fq;
#pragma unroll
        for (int ai = 0; ai < 2; ++ai)
#pragma unroll
            for (int m = 0; m < 4; ++m) { bf16_t* rowp = O + (size_t)(row0 + ai * HALF + m * 16) * ldc + col0;
#pragma unroll
                for (int bj = 0; bj < 2; ++bj) { const f32x4 v0 = acc[ai][bj][m][0], v1 = acc[ai][bj][m][1];
                    u32x4 w; w.x = cvt_pk_bf16(v0[0], v0[1]); w.y = cvt_pk_bf16(v0[2], v0[3]); w.z = cvt_pk_bf16(v1[0], v1[1]); w.w = cvt_pk_bf16(v1[2], v1[3]);
                    *(u32x4*)(rowp + bj * HALF) = w; } }
    }
};
struct EpiOut {
    static constexpr bool PERM = false, AFTER_DRAIN = false;
    const float *xp, *xs; bf16_t* XN; float* SSQ;
    __device__ __forceinline__ void operator()(f32x4 (&acc)[2][2][4][2], const Unit& u, int wr, int wc, int fr, int fq) const {
        const int row0 = u.pm * BM + wr * 64 + fr, col0 = u.pn * BM + wc * 32 + 4 * fq;
#pragma unroll
        for (int ai = 0; ai < 2; ++ai)
#pragma unroll
            for (int m = 0; m < 4; ++m) { const int row = row0 + ai * HALF + m * 16; float ss = 0.f;
                const float* src = row < 8192 ? xp + (size_t)row * 4096 : xs + (size_t)(row - 8192) * 4096; bf16_t* xb = XN + (size_t)row * 4096;
#pragma unroll
                for (int bj = 0; bj < 2; ++bj)
#pragma unroll
                    for (int n = 0; n < 2; ++n) { const int off = col0 + bj * HALF + n * 16; const f32x4 v = *(const f32x4*)(src + off) + acc[ai][bj][m][n];
                        ss += (v[0] * v[0] + v[1] * v[1]) + (v[2] * v[2] + v[3] * v[3]);
                        u32x2 w; w.x = cvt_pk_bf16(v[0], v[1]); w.y = cvt_pk_bf16(v[2], v[3]); *(u32x2*)(xb + off) = w; }
                ss += __shfl_xor(ss, 16); ss += __shfl_xor(ss, 32);
                if (fq == 0) SSQ[(size_t)row * 64 + u.pn * 4 + wc] = ss; }
    }
};
struct EpiPart {
    static constexpr bool PERM = false, AFTER_DRAIN = false;
    float* PART;
    __device__ __forceinline__ void operator()(f32x4 (&acc)[2][2][4][2], const Unit& u, int wr, int wc, int fr, int fq) const {
        const int col0 = u.pn * BM + wc * 32 + 4 * fq;
#pragma unroll
        for (int m = 0; m < 4; ++m) { const int row = wr * 64 + m * 16 + fr;
            if (row < 96) { float* dst = PART + ((size_t)u.ks * 96 + row) * 4096 + col0;
#pragma unroll
                for (int bj = 0; bj < 2; ++bj)
#pragma unroll
                    for (int n = 0; n < 2; ++n) *(f32x4*)(dst + bj * HALF + n * 16) = acc[0][bj][m][n]; } }
    }
};
struct MiniOrder {
    int pm, ncol, nks, G, c;
    __device__ bool next(int i, Unit& u) const { const int j = i * G + c; if (j >= ncol * nks) return false; u.pm = pm; u.pn = j % ncol; u.ks = j / ncol; return true; }
    __device__ __forceinline__ void a_ready(const Unit&) const {}
    __device__ __forceinline__ void done(const Unit&) const {}
};
struct EpiDown {
    static constexpr bool PERM = false, AFTER_DRAIN = false;
    bf16_t* X;
    __device__ __forceinline__ void operator()(f32x4 (&acc)[2][2][4][2], const Unit& u, int wr, int wc, int fr, int fq) const {
        const int row0 = u.pm * BM + wr * 64 + fr, col0 = u.pn * BM + wc * 32 + 4 * fq;
#pragma unroll
        for (int ai = 0; ai < 2; ++ai)
#pragma unroll
            for (int m = 0; m < 4; ++m) { bf16_t* rowp = X + (size_t)(row0 + ai * HALF + m * 16) * 4096 + col0;
#pragma unroll
                for (int bj = 0; bj < 2; ++bj)
#pragma unroll
                    for (int n = 0; n < 2; ++n) { bf16_t* p = rowp + bj * HALF + n * 16; const u32x2 w = *(const u32x2*)p; const f32x4 a = acc[ai][bj][m][n];
                        u32x2 o; o.x = cvt_pk_bf16(__builtin_bit_cast(float, w.x << 16) + a[0], __builtin_bit_cast(float, w.x & 0xffff0000u) + a[1]);
                        o.y = cvt_pk_bf16(__builtin_bit_cast(float, w.y << 16) + a[2], __builtin_bit_cast(float, w.y & 0xffff0000u) + a[3]); *(u32x2*)p = o; } }
    }
};

struct EpiNull {
    static constexpr bool PERM = true, AFTER_DRAIN = false;
    __device__ __forceinline__ void operator()(const f32x4 (&acc)[2][2][4][2], const Unit& u, int wr, int wc, int fr, int fq) const {
#pragma unroll
        for (int ai = 0; ai < 2; ++ai)
#pragma unroll
            for (int bj = 0; bj < 2; ++bj)
#pragma unroll
                for (int m = 0; m < 4; ++m)
#pragma unroll
                    for (int n = 0; n < 2; ++n) asm volatile("" :: "v"(acc[ai][bj][m][n]));
    }
};
struct EpiUpFused {
    static constexpr bool PERM = true, AFTER_DRAIN = false;
    bf16_t* H; const float* RSTD; const float* CS; const float* cw; const float* cb; float *EP, *EG, *EU, *EGM; PG8_LAS float* halo;
    __device__ __forceinline__ void operator()(f32x4 (&acc)[2][2][4][2], const Unit& u, int wr, int wc, int fr, int fq) const {
        const int lane = fq * 16 + fr, ft = wc * 32 + 8 * fq, f0 = u.pn * 128 + ft;
        float rs[2][4]; f32x4 su[2], sg[2];
#pragma unroll
        for (int ai = 0; ai < 2; ++ai)
#pragma unroll
            for (int m = 0; m < 4; ++m) rs[ai][m] = RSTD[u.pm * BM + ai * HALF + wr * 64 + m * 16 + fr];
#pragma unroll
        for (int n = 0; n < 2; ++n) { su[n] = *(const f32x4*)(CS + f0 + 4 * n); sg[n] = *(const f32x4*)(CS + 11008 + f0 + 4 * n); }
#pragma unroll
        for (int ai = 0; ai < 2; ++ai)
#pragma unroll
            for (int m = 0; m < 4; ++m)
#pragma unroll
                for (int n = 0; n < 2; ++n) {
                    acc[ai][1][m][n] = __builtin_convertvector(__builtin_bit_cast(i32x4, acc[ai][1][m][n]), f32x4) * (sg[n] * rs[ai][m]);
                    acc[ai][0][m][n] = __builtin_convertvector(__builtin_bit_cast(i32x4, acc[ai][0][m][n]), f32x4) * (su[n] * rs[ai][m]); }
        if (fr == 0) {
#pragma unroll
            for (int ai = 0; ai < 2; ++ai)
#pragma unroll
                for (int n = 0; n < 2; ++n) *(PG8_LAS f32x4*)(halo + (2 * ai + wr) * 128 + ft + 4 * n) = acc[ai][1][0][n]; }
        if (fr == 15) {
#pragma unroll
            for (int ai = 0; ai < 2; ++ai)
#pragma unroll
                for (int n = 0; n < 2; ++n) *(PG8_LAS f32x4*)(halo + (4 + 2 * ai + wr) * 128 + ft + 4 * n) = acc[ai][1][3][n]; }
        asm volatile("s_waitcnt lgkmcnt(0)" ::: "memory"); __builtin_amdgcn_s_barrier(); asm volatile("" ::: "memory");
        f32x4 w0[2], w1[2], w2[2], bb[2];
#pragma unroll
        for (int n = 0; n < 2; ++n) { w0[n] = *(const f32x4*)(cw + f0 + 4 * n); w1[n] = *(const f32x4*)(cw + 11008 + f0 + 4 * n); w2[n] = *(const f32x4*)(cw + 22016 + f0 + 4 * n); bb[n] = *(const f32x4*)(cb + f0 + 4 * n); }
        const int srcp = (lane & 48) | ((lane - 1) & 15), srcn = (lane & 48) | ((lane + 1) & 15);
        const bool meta_tile = (u.pm == 64);
#pragma unroll
        for (int ai = 0; ai < 2; ++ai) {
            f32x4 hp[2], hn[2];
            const bool has_p = !(ai == 0 && wr == 0), has_n = !(ai == 1 && wr == 1);
            const int sp = (wr == 1) ? 4 + 2 * ai : 4 + 1, sn = (wr == 0) ? 2 * ai + 1 : 2;
#pragma unroll
            for (int n = 0; n < 2; ++n) { hp[n] = has_p ? *(const PG8_LAS f32x4*)(halo + sp * 128 + ft + 4 * n) : (f32x4){0.f, 0.f, 0.f, 0.f};
                                          hn[n] = has_n ? *(const PG8_LAS f32x4*)(halo + sn * 128 + ft + 4 * n) : (f32x4){0.f, 0.f, 0.f, 0.f}; }
#pragma unroll
            for (int m = 0; m < 4; ++m) { const int rl = ai * HALF + wr * 64 + m * 16 + fr;
                f32x4 hv[2], gcs[2];
#pragma unroll
                for (int n = 0; n < 2; ++n) { const f32x4 gc = acc[ai][1][m][n]; gcs[n] = gc;
                    f32x4 tp = gc, tn = gc;
                    if (m > 0) { if (fr == 15) tp = acc[ai][1][m - 1][n]; }
                    if (m < 3) { if (fr == 0) tn = acc[ai][1][m + 1][n]; }
                    f32x4 gp, gn;
#pragma unroll
                    for (int j = 0; j < 4; ++j) { gp[j] = __shfl(tp[j], srcp); gn[j] = __shfl(tn[j], srcn); }
                    if (m == 0) { if (fr == 0) gp = hp[n]; }
                    if (m == 3) { if (fr == 15) gn = hn[n]; }
                    const f32x4 pre = w0[n] * gp + w1[n] * gc + w2[n] * gn + bb[n];
                    hv[n] = pre; }
                const bool edge0 = (rl == 0), edge1 = (rl == 255);
                if (meta_tile) {
                    if (ai == 0 && fr == 15 && rl < 96) { float* d = EGM + (size_t)(rl >> 4) * 11008 + f0; *(f32x4*)d = gcs[0]; *(f32x4*)(d + 4) = gcs[1]; }
                } else if (edge0 || edge1) { const size_t eo = ((size_t)u.pm * 2 + (edge1 ? 1 : 0)) * 11008 + f0;
                    *(f32x4*)(EP + eo) = hv[0]; *(f32x4*)(EP + eo + 4) = hv[1]; *(f32x4*)(EG + eo) = gcs[0]; *(f32x4*)(EG + eo + 4) = gcs[1];
                    *(f32x4*)(EU + eo) = acc[ai][0][m][0]; *(f32x4*)(EU + eo + 4) = acc[ai][0][m][1];
                } else { float o[8];
#pragma unroll
                    for (int n = 0; n < 2; ++n)
#pragma unroll
                        for (int j = 0; j < 4; ++j) { const float p = hv[n][j]; o[4 * n + j] = p * __builtin_amdgcn_rcpf(1.0f + __builtin_amdgcn_exp2f(-1.4426950408889634f * p)) * acc[ai][0][m][n][j]; }
                    u32x4 w; w.x = cvt_pk_bf16(o[0], o[1]); w.y = cvt_pk_bf16(o[2], o[3]); w.z = cvt_pk_bf16(o[4], o[5]); w.w = cvt_pk_bf16(o[6], o[7]);
                    *(u32x4*)(H + (size_t)(u.pm * BM + rl) * 11008 + f0) = w; } } }
    }
};
template <bool I8> __device__ __forceinline__ f32x4 mma16(const bf16x8 b, const bf16x8 a, const f32x4 c) {
    if constexpr (I8) return __builtin_bit_cast(f32x4, __builtin_amdgcn_mfma_i32_16x16x64_i8(__builtin_bit_cast(i32x4, b), __builtin_bit_cast(i32x4, a), __builtin_bit_cast(i32x4, c), 0, 0, 0));
    else return __builtin_amdgcn_mfma_f32_16x16x32_bf16(b, a, c, 0, 0, 0);
}
template <class Epi, class Sched, bool ALIGN_EPI = false, bool SP2 = false, int VAR = 0, bool I8 = false>
__device__ __forceinline__ void gemm_phase(PG8_LAS unsigned char* lds, const Gemm g, const Sched& S, const Epi& E) {
    const int tid = threadIdx.x, wid = __builtin_amdgcn_readfirstlane(tid >> 6), lane = tid & 63, wr = wid >> 2, wc = wid & 3, fr = lane & 15, fq = lane >> 4;
    const int K = g.K, nt = K / BK, ld = g.ld ? g.ld : g.K;
    unsigned voffA[2], voffB[2];
#pragma unroll
    for (int i = 0; i < 2; ++i) { int R, C; stage_rc(tid * 16 + i * 8192, R, C); const int Rb = Epi::PERM ? ((R & ~31) + perm32(R & 31)) : R;
        voffA[i] = (unsigned)(R * ld + C) * 2u; voffB[i] = (unsigned)(Rb * ld + C) * 2u; }
    const size_t kstep = (VAR == 1) ? (size_t)0 : (size_t)(BK * 2);
    const size_t hstep = (size_t)HALF * ld * 2;
    const size_t tstep = 2 * hstep;
    const unsigned ldsw = (unsigned)wid * 1024u;
    const int aoff = (VAR == 6) ? lane * 16 : lds_byte(wr * 64 + fr, fq * 8), boff = (VAR == 6) ? lane * 16 : lds_byte(wc * 32 + fr, fq * 8);
#define PG8_SA(b, h) (((b) * 2 + (h)) * HTB)
#define PG8_SB(b, h) ((4 + (b) * 2 + (h)) * HTB)
#define PG8_STAGE(bufoff, gbase, voff) do { if (VAR != 3 && VAR != 4) _Pragma("unroll") for (int _i = 0; _i < 2; ++_i) \
        __builtin_amdgcn_global_load_lds((const unsigned*)((const char*)(gbase) + (voff)[_i]), (PG8_LAS unsigned*)(lds + (bufoff) + ldsw + _i * 8192), 16, 0, 0); } while (0)
#define PG8_LDA(dst, b, h) do { if (VAR != 4) _Pragma("unroll") for (int m = 0; m < 4; ++m) _Pragma("unroll") for (int k = 0; k < 2; ++k) dst[m][k] = *(const PG8_LAS bf16x8*)(lds + PG8_SA(b, h) + aoff + m * 2048 + k * 1024); } while (0)
#define PG8_LDB(dst, b, h) do { if (VAR != 4) _Pragma("unroll") for (int n = 0; n < 2; ++n) _Pragma("unroll") for (int k = 0; k < 2; ++k) dst[n][k] = *(const PG8_LAS bf16x8*)(lds + PG8_SB(b, h) + boff + n * 2048 + k * 1024); } while (0)
#define PG8_MMA(ai, bj, At, Bt) do { if (VAR == 11) __builtin_amdgcn_s_setprio(3); else if (VAR != 8 && VAR != 9) __builtin_amdgcn_s_setprio(1); if (VAR != 2) _Pragma("unroll") for (int m = 0; m < 4; ++m) _Pragma("unroll") for (int n = 0; n < 2; ++n) _Pragma("unroll") for (int k = 0; k < 2; ++k) \
        acc[ai][bj][m][n] = mma16<I8>(Bt[n][k], At[m][k], acc[ai][bj][m][n]); if (VAR == 10) __builtin_amdgcn_s_setprio(2); else if (VAR == 11) __builtin_amdgcn_s_setprio(1); else if (VAR != 8 && VAR != 9) __builtin_amdgcn_s_setprio(0); } while (0)
#define PG8_WAIT_V(n) asm volatile("s_waitcnt vmcnt(" #n ")" ::: "memory")
#define PG8_WAIT_L(n) asm volatile("s_waitcnt lgkmcnt(" #n ")" ::: "memory")
#define PG8_BAR __builtin_amdgcn_s_barrier()
#define PG8_SCHED __builtin_amdgcn_sched_barrier(0)
    Unit cur, nxt; int ui = 0;
    if (VAR == 9) { if (wr == 1) __builtin_amdgcn_s_setprio(1); }
    if (!S.next(0, cur)) return;
    f32x4 acc[2][2][4][2];
#pragma unroll
    for (int a = 0; a < 2; ++a)
#pragma unroll
        for (int b = 0; b < 2; ++b)
#pragma unroll
            for (int m = 0; m < 4; ++m)
#pragma unroll
                for (int n = 0; n < 2; ++n) acc[a][b][m][n] = (f32x4){0.f, 0.f, 0.f, 0.f};
    bf16x8 At[4][2], B0[2][2], B1[2][2];
    if (VAR == 4) { const short sv = (short)(0x3c00 + tid);
#pragma unroll
        for (int m = 0; m < 4; ++m) for (int k = 0; k < 2; ++k) { At[m][k] = (bf16x8){sv, sv, sv, sv, sv, sv, sv, sv}; asm volatile("" : "+v"(At[m][k])); }
#pragma unroll
        for (int n = 0; n < 2; ++n) for (int k = 0; k < 2; ++k) { B0[n][k] = (bf16x8){sv, sv, sv, sv, sv, sv, sv, sv}; B1[n][k] = B0[n][k]; asm volatile("" : "+v"(B0[n][k])); asm volatile("" : "+v"(B1[n][k])); } }
    const char* cA = (const char*)g.A + (size_t)cur.pm * tstep + (size_t)cur.ks * K * 2; const char* cB = (const char*)g.Bt + (size_t)cur.pn * tstep + (size_t)cur.ks * K * 2;
    S.a_ready(cur);
    if constexpr (SP2) {
        PG8_STAGE(PG8_SB(0, 0), cB, voffB); PG8_STAGE(PG8_SB(0, 1), cB + hstep, voffB); PG8_STAGE(PG8_SA(0, 0), cA, voffA); PG8_STAGE(PG8_SA(0, 1), cA + hstep, voffA);
        if (wr == 1) PG8_BAR;
        PG8_WAIT_V(2); PG8_BAR;
        PG8_STAGE(PG8_SB(1, 0), cB + kstep, voffB); PG8_STAGE(PG8_SA(1, 0), cA + kstep, voffA); PG8_STAGE(PG8_SB(1, 1), cB + hstep + kstep, voffB);
        PG8_WAIT_V(6); PG8_BAR;
    } else {
        PG8_STAGE(PG8_SB(0, 0), cB, voffB); PG8_STAGE(PG8_SA(0, 0), cA, voffA); PG8_STAGE(PG8_SB(0, 1), cB + hstep, voffB); PG8_STAGE(PG8_SA(0, 1), cA + hstep, voffA);
        if (wr == 1) PG8_BAR;
        PG8_WAIT_V(4); PG8_BAR;
        PG8_STAGE(PG8_SB(1, 0), cB + kstep, voffB); PG8_STAGE(PG8_SA(1, 0), cA + kstep, voffA); PG8_STAGE(PG8_SB(1, 1), cB + hstep + kstep, voffB);
        PG8_WAIT_V(6); PG8_BAR;
    }
    for (;;) {
        const bool has_next = S.next(ui + 1, nxt);
        const char* nA = has_next ? (const char*)g.A + (size_t)nxt.pm * tstep + (size_t)nxt.ks * K * 2 : cA; const char* nB = has_next ? (const char*)g.Bt + (size_t)nxt.pn * tstep + (size_t)nxt.ks * K * 2 : cB;
        for (int t = 0; t < nt; t += 2) {
            const bool last = (t == nt - 2);
            const char* a1 = cA + (size_t)(t + 1) * kstep;
            const char* a2 = last ? nA : cA + (size_t)(t + 2) * kstep; const char* b2 = last ? nB : cB + (size_t)(t + 2) * kstep;
            const char* a3 = a2 + kstep; const char* b3 = b2 + kstep;
            if (last && has_next) S.a_ready(nxt);
            if constexpr (SP2 && VAR == 5) {
            PG8_LDB(B0, 0, 0); PG8_LDB(B1, 0, 1); PG8_SCHED; PG8_LDA(At, 0, 0);
            PG8_WAIT_V(6); PG8_WAIT_L(0); PG8_BAR; PG8_MMA(0, 0, At, B0); PG8_SCHED; PG8_STAGE(PG8_SA(1, 1), a1 + hstep, voffA); PG8_SCHED; PG8_MMA(0, 1, At, B1); PG8_BAR; PG8_SCHED;
            PG8_LDA(At, 0, 1);
            PG8_WAIT_V(2); PG8_WAIT_L(0); PG8_BAR; PG8_MMA(1, 0, At, B0); PG8_SCHED; PG8_STAGE(PG8_SB(0, 0), b2, voffB); PG8_STAGE(PG8_SB(0, 1), b2 + hstep, voffB); PG8_STAGE(PG8_SA(0, 0), a2, voffA); PG8_SCHED; PG8_MMA(1, 1, At, B1); PG8_BAR; PG8_SCHED;
            PG8_LDB(B0, 1, 0); PG8_LDB(B1, 1, 1); PG8_SCHED; PG8_LDA(At, 1, 0);
            PG8_WAIT_V(6); PG8_WAIT_L(0); PG8_BAR; PG8_MMA(0, 0, At, B0); PG8_SCHED; PG8_STAGE(PG8_SA(0, 1), a2 + hstep, voffA); PG8_SCHED; PG8_MMA(0, 1, At, B1); PG8_BAR; PG8_SCHED;
            PG8_LDA(At, 1, 1);
            PG8_WAIT_V(2); PG8_WAIT_L(0); PG8_BAR; PG8_MMA(1, 0, At, B0); PG8_SCHED; PG8_STAGE(PG8_SB(1, 0), b3, voffB); PG8_STAGE(PG8_SB(1, 1), b3 + hstep, voffB); PG8_STAGE(PG8_SA(1, 0), a3, voffA); PG8_SCHED; PG8_MMA(1, 1, At, B1); PG8_BAR; PG8_SCHED;
            } else if constexpr (SP2) {
            PG8_LDB(B0, 0, 0); PG8_LDB(B1, 0, 1); PG8_SCHED; PG8_LDA(At, 0, 0); PG8_STAGE(PG8_SA(1, 1), a1 + hstep, voffA);
            PG8_WAIT_V(8); PG8_WAIT_L(0); PG8_BAR; PG8_MMA(0, 0, At, B0); PG8_MMA(0, 1, At, B1); PG8_BAR; PG8_SCHED;
            if (VAR != 7) PG8_LDA(At, 0, 1); PG8_STAGE(PG8_SB(0, 0), b2, voffB); PG8_STAGE(PG8_SB(0, 1), b2 + hstep, voffB); PG8_STAGE(PG8_SA(0, 0), a2, voffA);
            PG8_WAIT_V(8); PG8_WAIT_L(0); PG8_BAR; PG8_MMA(1, 0, At, B0); PG8_MMA(1, 1, At, B1); PG8_BAR; PG8_SCHED;
            PG8_LDB(B0, 1, 0); PG8_LDB(B1, 1, 1); PG8_SCHED; PG8_LDA(At, 1, 0); PG8_STAGE(PG8_SA(0, 1), a2 + hstep, voffA);
            PG8_WAIT_V(8); PG8_WAIT_L(0); PG8_BAR; PG8_MMA(0, 0, At, B0); PG8_MMA(0, 1, At, B1); PG8_BAR; PG8_SCHED;
            if (VAR != 7) PG8_LDA(At, 1, 1); PG8_STAGE(PG8_SB(1, 0), b3, voffB); PG8_STAGE(PG8_SB(1, 1), b3 + hstep, voffB); PG8_STAGE(PG8_SA(1, 0), a3, voffA);
            PG8_WAIT_V(8); PG8_WAIT_L(0); PG8_BAR; PG8_MMA(1, 0, At, B0); PG8_MMA(1, 1, At, B1); PG8_BAR; PG8_SCHED;
            } else {
            PG8_LDB(B0, 0, 0); PG8_SCHED; PG8_LDA(At, 0, 0); PG8_STAGE(PG8_SA(1, 1), a1 + hstep, voffA);
            PG8_WAIT_L(8); PG8_BAR; PG8_WAIT_L(0); PG8_MMA(0, 0, At, B0); PG8_BAR; PG8_SCHED;
            PG8_LDB(B1, 0, 1); PG8_STAGE(PG8_SB(0, 0), b2, voffB);
            PG8_BAR; PG8_WAIT_L(0); PG8_MMA(0, 1, At, B1); PG8_BAR;
            PG8_LDA(At, 0, 1); PG8_STAGE(PG8_SA(0, 0), a2, voffA);
            PG8_BAR; PG8_WAIT_L(0); PG8_MMA(1, 0, At, B0); PG8_BAR; PG8_SCHED;
            PG8_STAGE(PG8_SB(0, 1), b2 + hstep, voffB);
            PG8_WAIT_V(6); PG8_BAR; PG8_MMA(1, 1, At, B1); PG8_BAR;
            PG8_LDB(B0, 1, 0); PG8_SCHED; PG8_LDA(At, 1, 0); PG8_STAGE(PG8_SA(0, 1), a2 + hstep, voffA);
            PG8_WAIT_L(8); PG8_BAR; PG8_WAIT_L(0); PG8_MMA(0, 0, At, B0); PG8_BAR; PG8_SCHED;
            PG8_LDB(B1, 1, 1); PG8_STAGE(PG8_SB(1, 0), b3, voffB);
            PG8_BAR; PG8_WAIT_L(0); PG8_MMA(0, 1, At, B1); PG8_BAR;
            PG8_LDA(At, 1, 1); PG8_STAGE(PG8_SA(1, 0), a3, voffA);
            PG8_BAR; PG8_WAIT_L(0); PG8_MMA(1, 0, At, B0); PG8_BAR; PG8_SCHED;
            PG8_STAGE(PG8_SB(1, 1), b3 + hstep, voffB);
            PG8_WAIT_V(6); PG8_BAR; PG8_MMA(1, 1, At, B1); PG8_BAR;
            }
        }
        if constexpr (ALIGN_EPI) { if (wr == 0) PG8_BAR; }
        if constexpr (!Epi::AFTER_DRAIN) { E(acc, cur, wr, wc, fr, fq); S.done(cur); }
        if (!has_next) break;
#pragma unroll
        for (int a = 0; a < 2; ++a)
#pragma unroll
            for (int b = 0; b < 2; ++b)
#pragma unroll
                for (int m = 0; m < 4; ++m)
#pragma unroll
                    for (int n = 0; n < 2; ++n) acc[a][b][m][n] = (f32x4){0.f, 0.f, 0.f, 0.f};
        cur = nxt; cA = nA; cB = nB; ++ui;
        if constexpr (ALIGN_EPI) { if (wr == 1) PG8_BAR; }
    }
    PG8_WAIT_V(0);
    if constexpr (!ALIGN_EPI) { if (wr == 0) PG8_BAR; }
    PG8_BAR;
    if constexpr (Epi::AFTER_DRAIN) { E.fused(acc, cur, wr, wc, fr, fq, lds, wid, lane); S.done(cur); }
#undef PG8_SA
#undef PG8_SB
#undef PG8_STAGE
#undef PG8_LDA
#undef PG8_LDB
#undef PG8_MMA
#undef PG8_WAIT_V
#undef PG8_WAIT_L
#undef PG8_BAR
#undef PG8_SCHED
}
}
#define GAS __attribute__((address_space(1)))
#define LAS __attribute__((address_space(3)))
typedef unsigned short bf16;
typedef unsigned v4u __attribute__((ext_vector_type(4)));
typedef float f32x4 __attribute__((ext_vector_type(4)));
typedef short bf16x8 __attribute__((ext_vector_type(8)));
typedef GAS unsigned gu32;
typedef GAS unsigned long long gu64;
#define RLX_AGENT __ATOMIC_RELAXED, __HIP_MEMORY_SCOPE_AGENT
#define LDS_WAIT() asm volatile("s_waitcnt lgkmcnt(0)" ::: "memory")
#define VM_WAIT() asm volatile("s_waitcnt vmcnt(0)" ::: "memory")
__device__ __forceinline__ unsigned long long rt() { return __builtin_amdgcn_s_memrealtime(); }
__device__ __forceinline__ unsigned f2bf(float f) { unsigned u = __builtin_bit_cast(unsigned, f); return (u + 0x7fffu + ((u >> 16) & 1u)) >> 16; }
__device__ __forceinline__ unsigned pk2(float lo, float hi) { return f2bf(lo) | (f2bf(hi) << 16); }

#define XB_TMO      128
#define XB_XCNT(j)  (256  + 64 * (j))
#define XB_XSUB(j)  (1280 + 64 * (j))
#define XB_XGEN(j)  (2304 + 64 * (j))
#define XB_TOP      3328
#define XB_TOPGEN   3392
#define XCD_BAR_WORDS 3456
#define XB_SPIN_CAP (1u << 18)

__device__ __forceinline__ unsigned xb_ld(unsigned* p)              { return __hip_atomic_load(p, __ATOMIC_RELAXED, __HIP_MEMORY_SCOPE_AGENT); }
__device__ __forceinline__ unsigned xb_add(unsigned* p, unsigned v) { return __hip_atomic_fetch_add(p, v, __ATOMIC_RELAXED, __HIP_MEMORY_SCOPE_AGENT); }
__device__ __forceinline__ unsigned xb_xcc_id() { return (unsigned)__builtin_amdgcn_s_getreg((3 << 11) | 20) & 0xFu; }
#define XB_SPIN(cond, bar) do { unsigned _sp = 0; while (cond) { __builtin_amdgcn_s_sleep(1); \
    if ((++_sp & 255u) == 0u) { if (xb_ld(&(bar)[XB_TMO])) break; if (_sp > XB_SPIN_CAP) { atomicAdd(&(bar)[XB_TMO], 1u); break; } } } } while (0)

struct XcdBarrier {
    unsigned* bar; unsigned x;
    volatile LAS unsigned* st;
};

__device__ __forceinline__ XcdBarrier xcd_barrier_post(unsigned* bar, volatile LAS unsigned* st) {
    XcdBarrier b; b.bar = bar; b.x = xb_xcc_id(); b.st = st;
    if (threadIdx.x == 0) (void)xb_add(&bar[XB_XCNT(b.x)], 1u);
    return b;
}
__device__ __forceinline__ void xcd_barrier_complete(unsigned* bar, unsigned x, unsigned& nloc, unsigned& nx) {
    const unsigned G = gridDim.x * gridDim.y * gridDim.z;
    unsigned sum, cnt, mine, sp = 0u;
    for (;;) {
        sum = 0u; cnt = 0u; mine = 0u;
#pragma unroll
        for (unsigned j = 0; j < 16; ++j) { const unsigned c = xb_ld(&bar[XB_XCNT(j)]); sum += c; cnt += (c > 0u) ? 1u : 0u; mine = (j == x) ? c : mine; }
        if (sum == G) break;
        __builtin_amdgcn_s_sleep(1);
        if ((++sp & 255u) == 0u) { if (xb_ld(&bar[XB_TMO])) break; if (sp > XB_SPIN_CAP) { atomicAdd(&bar[XB_TMO], 1u); break; } }
    }
    nloc = mine > 0u ? mine : 1u; nx = cnt > 0u ? cnt : 1u;
}

__device__ __forceinline__ void xcd_barrier(const XcdBarrier& b) {
    asm volatile("s_waitcnt vmcnt(0)" ::: "memory");
    __syncthreads();
    if (threadIdx.x == 0) {
        unsigned* bar = b.bar;
        __builtin_amdgcn_s_waitcnt(0);
        unsigned nloc = b.st[0], nx = b.st[1];
        if (nloc == 0u) { xcd_barrier_complete(bar, b.x, nloc, nx); b.st[0] = nloc; b.st[1] = nx; }
        const unsigned old = xb_add(&bar[XB_XSUB(b.x)], 1u);
        const unsigned gen = old / nloc;
        if (old + 1u == (gen + 1u) * nloc) {
            __builtin_amdgcn_fence(__ATOMIC_RELEASE, "agent");
            asm volatile("s_waitcnt vmcnt(0)" ::: "memory");
            const unsigned og = xb_add(&bar[XB_TOP], 1u);
            const unsigned tg = og / nx;
            if (og + 1u == (tg + 1u) * nx) xb_add(&bar[XB_TOPGEN], 1u);
            else XB_SPIN(xb_ld(&bar[XB_TOPGEN]) == tg, bar);
            __builtin_amdgcn_fence(__ATOMIC_ACQUIRE, "agent");
            xb_add(&bar[XB_XGEN(b.x)], 1u);
            asm volatile("s_waitcnt vmcnt(0)" ::: "memory");
        } else {
            XB_SPIN(xb_ld(&bar[XB_XGEN(b.x)]) == gen, bar);
            __builtin_amdgcn_fence(__ATOMIC_ACQUIRE, "agent");
            asm volatile("s_waitcnt vmcnt(0)" ::: "memory");
        }
    }
    __syncthreads();
}
constexpr int NWAVES = 8;
constexpr int DM = 4096, DFF = 11008, NUP = 2 * DFF, NI = 12544;
constexpr int MREAL = 16384, MTOK = 16480, MP = 16640;
constexpr int NITEM = 2096;
constexpr int NCSEQ = 262;
constexpr float EPS = 1e-6f;
constexpr size_t MiB = 1u << 20;
constexpr size_t WS_CTL = 0, CTL_ZERO_BYTES = 65536;
constexpr size_t WS_AD = 1 * MiB;
constexpr size_t WS_X1M = 4 * MiB;
constexpr size_t WS_WD = 6 * MiB;
constexpr size_t WS_WI = 92 * MiB;
constexpr size_t WS_WO = 190 * MiB;
constexpr size_t WS_WU = 222 * MiB;
constexpr size_t WS_XQ = 308 * MiB;
constexpr size_t WS_CMAXP = 374 * MiB;
constexpr size_t WS_CS = 380 * MiB;
constexpr size_t WS_RFI = 381 * MiB;
constexpr int NI8T = 24, NI8C = NI8T * 256;
constexpr int CW_CMI = 8192;
constexpr size_t WS_XN = 394 * MiB;
constexpr size_t WS_PQK = 524 * MiB;
constexpr size_t WS_PC = 589 * MiB;
constexpr size_t WS_PV = 784 * MiB;
constexpr size_t WS_PR = 849 * MiB;
constexpr size_t WS_QT = 914 * MiB;
constexpr size_t WS_KT = 980 * MiB;
constexpr size_t WS_KH = 1046 * MiB;
constexpr size_t WS_ED = 1112 * MiB;
constexpr size_t WS_MIX = 1115 * MiB;
constexpr size_t WS_VT = 1245 * MiB;
constexpr size_t WS_END = 1335 * MiB;
constexpr size_t WS_O2 = WS_PQK;
constexpr size_t WS_H = WS_PQK;
constexpr size_t WS_EP = 870 * MiB, WS_EG = 876 * MiB, WS_EU = 882 * MiB;
constexpr size_t WS_EGM = 888 * MiB;
constexpr size_t WS_SSQ = 889 * MiB;
constexpr size_t WS_RSTD = 894 * MiB;
constexpr size_t WS_PART = 1311 * MiB;
static_assert(WS_H + (size_t)MREAL * DFF * 2 <= WS_EP && WS_EP + (size_t)64 * 2 * DFF * 4 <= WS_EG && WS_EGM + (size_t)6 * DFF * 4 <= WS_SSQ && WS_SSQ + (size_t)MP * 64 * 4 <= WS_RSTD && WS_RSTD + (size_t)MP * 4 <= WS_QT && WS_O2 + (size_t)2 * MP * 2048 * 2 <= WS_PV, "ws map");
static_assert(WS_QT + (size_t)2 * NITEM * 8192 * 2 <= WS_KT && WS_KH + (size_t)2 * NITEM * 8192 * 2 <= WS_ED && WS_ED + (size_t)2 * NITEM * 128 * 4 <= WS_MIX, "ws map 2");
constexpr int CW_BAR = 4096;
constexpr int CW_Q = 64;
constexpr int RING_BYTES = 131072, MISC_OFF = RING_BYTES + 320, LDS_BYTES = 147456;
constexpr int NPHASE = 12;
#ifndef MK_ONE_LAUNCH
#define MK_ONE_LAUNCH 1
#endif

typedef float f32x2v __attribute__((ext_vector_type(2)));
typedef unsigned u32x2v __attribute__((ext_vector_type(2)));

__device__ __forceinline__ float wave_sum(float v) {
#pragma unroll
    for (int o = 1; o < 64; o <<= 1) v += __shfl_xor(v, o);
    return v;
}
__device__ __forceinline__ float wave_max(float v) {
#pragma unroll
    for (int o = 1; o < 64; o <<= 1) v = fmaxf(v, __shfl_xor(v, o));
    return v;
}
__device__ __forceinline__ unsigned q8(float f) { return __builtin_bit_cast(unsigned, f + 12582912.0f) & 0xffu; }
__device__ __forceinline__ unsigned q8x4(float a, float b, float c, float d) { return q8(a) | (q8(b) << 8) | (q8(c) << 16) | (q8(d) << 24); }
__device__ __forceinline__ unsigned cvtpk(float lo, float hi) { return pg8::cvt_pk_bf16(lo, hi); }
__device__ __forceinline__ float bflo(unsigned w) { return __builtin_bit_cast(float, w << 16); }
__device__ __forceinline__ float bfhi(unsigned w) { return __builtin_bit_cast(float, w & 0xffff0000u); }
__device__ __forceinline__ float bf1(unsigned short h) { return __builtin_bit_cast(float, (unsigned)h << 16); }

__device__ __forceinline__ int seq_rowbase(int s) { return s < 2 ? s * 4096 : 8192 + (s - 2) * 2048; }
__device__ __forceinline__ int seq_len(int s) { return s < 2 ? 4096 : 2048; }
__device__ __forceinline__ int seq_nchunks(int s) { return s < 2 ? 65 : 33; }
__device__ __forceinline__ int seq_chunkbase(int s) { return s < 2 ? s * 65 : 130 + (s - 2) * 33; }
__device__ __forceinline__ void cs_decode(int cs, int& s, int& c) { if (cs < 130) { s = cs >= 65 ? 1 : 0; c = cs - s * 65; } else { const int j = cs - 130; s = 2 + j / 33; c = j - (s - 2) * 33; } }
__device__ __forceinline__ int chunk_row(int s, int c, int i) { return c == 0 ? (i < 48 ? -1 : 16384 + 16 * s + (i - 48)) : seq_rowbase(s) + 64 * (c - 1) + i; }
__device__ __forceinline__ int pos_row(int s, int p) { return p < 16 ? 16384 + 16 * s + p : seq_rowbase(s) + p - 16; }

struct CvDesc { const float* src; const float* ks; const float* cs; void* dst; int N, K, kind; };
struct CvRegs { f32x4 v[8]; float kv, cs; };
__device__ __forceinline__ void cv_load(const CvDesc& d, CvRegs& R, int lane) {
    const int kr = lane >> 3, nc4 = 4 * (lane & 7);
#pragma unroll
    for (int i = 0; i < 8; ++i) R.v[i] = __builtin_nontemporal_load((const GAS f32x4*)(d.src + (size_t)(kr + 8 * i) * d.N + nc4));
    R.kv = *(const GAS float*)(d.ks + lane);
    R.cs = *(const GAS float*)(d.cs + (lane & 31));
}
__device__ __forceinline__ void cv_finish(const CvDesc& d, CvRegs& R, LAS float* scr, int lane) {
    const int kr = lane >> 3, nc4 = 4 * (lane & 7);
#pragma unroll
    for (int i = 0; i < 8; ++i) { LAS float* p = scr + (kr + 8 * i) * 33 + nc4; p[0] = R.v[i].x; p[1] = R.v[i].y; p[2] = R.v[i].z; p[3] = R.v[i].w; }
    scr[64 * 33 + lane] = R.kv; if (lane < 32) scr[64 * 33 + 64 + lane] = R.cs;
    LDS_WAIT(); asm volatile("" ::: "memory");
    if (d.kind != 0) {
        const int c = lane & 3; const float cmul = d.kind == 2 ? (1.0f / 127.0f) : 1.0f;
        f32x4 kq[4];
#pragma unroll
        for (int i = 0; i < 4; ++i) { kq[i] = *(const LAS f32x4*)(scr + 64 * 33 + 16 * c + 4 * i); if (d.kind == 2) kq[i] = (f32x4){1.f, 1.f, 1.f, 1.f}; }
#pragma unroll
        for (int j = 0; j < 2; ++j) { const int n = (lane >> 2) + 16 * j; const LAS float* sp = scr + (16 * c) * 33 + n;
            const float cn = scr[64 * 33 + 64 + n] * cmul, inv = cn > 0.f ? __builtin_amdgcn_rcpf(cn) : 0.f;
            v4u o;
            o.x = q8x4(sp[0 * 33] * kq[0].x * inv, sp[1 * 33] * kq[0].y * inv, sp[2 * 33] * kq[0].z * inv, sp[3 * 33] * kq[0].w * inv);
            o.y = q8x4(sp[4 * 33] * kq[1].x * inv, sp[5 * 33] * kq[1].y * inv, sp[6 * 33] * kq[1].z * inv, sp[7 * 33] * kq[1].w * inv);
            o.z = q8x4(sp[8 * 33] * kq[2].x * inv, sp[9 * 33] * kq[2].y * inv, sp[10 * 33] * kq[2].z * inv, sp[11 * 33] * kq[2].w * inv);
            o.w = q8x4(sp[12 * 33] * kq[3].x * inv, sp[13 * 33] * kq[3].y * inv, sp[14 * 33] * kq[3].z * inv, sp[15 * 33] * kq[3].w * inv);
            *(GAS v4u*)((unsigned char*)d.dst + (size_t)n * d.K + 16 * c) = o; }
    } else {
        const int c = lane & 7;
#pragma unroll
        for (int j = 0; j < 4; ++j) { const int n = (lane >> 3) + 8 * j; const LAS float* sp = scr + (8 * c) * 33 + n;
            v4u o; o.x = cvtpk(sp[0 * 33], sp[1 * 33]); o.y = cvtpk(sp[2 * 33], sp[3 * 33]); o.z = cvtpk(sp[4 * 33], sp[5 * 33]); o.w = cvtpk(sp[6 * 33], sp[7 * 33]);
            *(GAS v4u*)((bf16*)d.dst + (size_t)n * d.K + 8 * c) = o; }
    }
    LDS_WAIT(); asm volatile("" ::: "memory");
}
constexpr int CV_NB_I = 12320 / 32, CV_I_I = (DM / 64) * CV_NB_I;
constexpr int CV_NB_O = DM / 32, CV_NB_U = NUP / 32, CV_NB_D = DM / 32, CV_I_O = (DM / 64) * CV_NB_O, CV_I_U = (DM / 64) * CV_NB_U, CV_I_D = (DFF / 64) * CV_NB_D, CV_I_REST = CV_I_O + CV_I_U + CV_I_D;
__device__ __forceinline__ int in_src_col(int n0) {
    if (n0 < 4096) return n0 + 2048; if (n0 < 6144) return n0 - 4096; if (n0 < 8192) return n0 + 32; if (n0 >= 12288) return 6144;
    const int o = n0 - 8192; return ((o & 128) ? 10272 : 8224) + 128 * (o >> 8) + (o & 127);
}
__device__ __forceinline__ CvDesc cv_desc_in(int it, const float* w_in, const float* dummy, const float* CMI, bf16* WI) {
    const int kb = it / CV_NB_I, nb = it - kb * CV_NB_I, n0 = 32 * nb;
    CvDesc d; d.src = w_in + (size_t)(64 * kb) * 12320 + in_src_col(n0); d.ks = dummy; d.N = 12320;
    if (n0 < NI8C) { d.cs = CMI + n0; d.dst = (unsigned char*)WI + (size_t)n0 * DM + 64 * kb; d.K = DM; d.kind = 2; }
    else { d.cs = dummy; d.dst = WI + (size_t)n0 * DM + 64 * kb; d.K = DM; d.kind = 0; }
    return d;
}
__device__ __forceinline__ CvDesc cv_desc_rest(int it, const float* w_out, const float* w_up, const float* w_down, const float* ffn_g, const float* CS, bf16* WO, unsigned char* WU, bf16* WD) {
    CvDesc d; int r = it;
    if (r < CV_I_O) { const int kb = r / CV_NB_O, nb = r - kb * CV_NB_O; d.src = w_out + (size_t)(64 * kb) * DM + 32 * nb; d.ks = ffn_g; d.cs = ffn_g; d.dst = WO + (size_t)(32 * nb) * DM + 64 * kb; d.N = DM; d.K = DM; d.kind = 0; return d; }
    r -= CV_I_O;
    if (r < CV_I_U) { const int kb = r / CV_NB_U, nb = r - kb * CV_NB_U, pn = nb >> 3, j = nb & 7;
        const int srcn = j < 4 ? 128 * pn + 32 * j : DFF + 128 * pn + 32 * (j - 4);
        d.src = w_up + (size_t)(64 * kb) * NUP + srcn; d.ks = ffn_g + 64 * kb; d.cs = CS + srcn; d.dst = WU + (size_t)(32 * nb) * DM + 64 * kb; d.N = NUP; d.K = DM; d.kind = 1; return d; }
    r -= CV_I_U;
    { const int kb = r / CV_NB_D, nb = r - kb * CV_NB_D; d.src = w_down + (size_t)(64 * kb) * DM + 32 * nb; d.ks = ffn_g; d.cs = ffn_g; d.dst = WD + (size_t)(32 * nb) * DFF + 64 * kb; d.N = DM; d.K = DFF; d.kind = 0; return d; }
}
__device__ __forceinline__ void norm_row_q(const float* xrow, const float* g, bf16* orow, unsigned char* qrow, float* rf, int lane) {
    f32x4 v[16]; float s = 0.f;
#pragma unroll
    for (int j = 0; j < 8; ++j) { const GAS f32x4* p = (const GAS f32x4*)(xrow + 8 * lane + 512 * j); v[2 * j] = __builtin_nontemporal_load(p); v[2 * j + 1] = __builtin_nontemporal_load(p + 1); }
#pragma unroll
    for (int j = 0; j < 16; ++j) s += (v[j].x * v[j].x + v[j].y * v[j].y) + (v[j].z * v[j].z + v[j].w * v[j].w);
    const float rstd = 1.0f / sqrtf(wave_sum(s) * (1.0f / 4096.0f) + EPS);
    float amax = 0.f;
#pragma unroll
    for (int j = 0; j < 8; ++j) { const GAS f32x4* gp = (const GAS f32x4*)(g + 8 * lane + 512 * j); const f32x4 a = v[2 * j] * rstd * gp[0], b = v[2 * j + 1] * rstd * gp[1]; v[2 * j] = a; v[2 * j + 1] = b;
        amax = fmaxf(amax, fmaxf(fmaxf(fmaxf(fabsf(a.x), fabsf(a.y)), fmaxf(fabsf(a.z), fabsf(a.w))), fmaxf(fmaxf(fabsf(b.x), fabsf(b.y)), fmaxf(fabsf(b.z), fabsf(b.w)))));
        v4u o; o.x = cvtpk(a.x, a.y); o.y = cvtpk(a.z, a.w); o.z = cvtpk(b.x, b.y); o.w = cvtpk(b.z, b.w); *(GAS v4u*)(orow + 8 * lane + 512 * j) = o; }
    amax = wave_max(amax); const float sc = amax > 0.f ? 127.0f / amax : 0.f;
#pragma unroll
    for (int j = 0; j < 8; ++j) { const f32x4 a = v[2 * j] * sc, b = v[2 * j + 1] * sc; u32x2v o; o.x = q8x4(a.x, a.y, a.z, a.w); o.y = q8x4(b.x, b.y, b.z, b.w); *(GAS u32x2v*)(qrow + 8 * lane + 512 * j) = o; }
    if (lane == 0) *rf = amax * (1.0f / 127.0f);
}

__device__ __forceinline__ float fexp(float x) { return __builtin_amdgcn_exp2f(x * 1.4426950408889634f); }
__device__ __forceinline__ float logsig16(float x) { return (fminf(x, 0.f) - __builtin_amdgcn_logf(1.0f + fexp(-fabsf(x))) * 0.6931471805599453f) * 0.0625f; }
template <int PVAR> __device__ __forceinline__ void prep_item(int it, LAS unsigned char* lds, const float* AD, const bf16* PQK, const bf16* PV, const float* wg2, const float* bg2, bf16* QT, bf16* KT, bf16* KH, float* ED, bf16* VT, int tid, int wave, int lane) {
    const int cs = it >> 3, h = it & 7; int s, c; cs_decode(cs, s, c);
    asm volatile("" : "+v"(tid)); lane = tid & 63;
    LAS float* sA = (LAS float*)lds;
    LAS float* sT = (LAS float*)(lds + 8192);
    const int dp = lane, tg = wave, fr = lane & 15, fq = lane >> 4, tb = wave >> 1;
    const int rowa = chunk_row(s, c, tid >> 3), rowv = chunk_row(s, c, 16 * tb + fr);
    f32x4 a4 = *(const GAS f32x4*)(AD + (size_t)(rowa >= 0 ? rowa : 0) * 32 + (tid & 7) * 4);
    unsigned qw[8], kw[8];
#pragma unroll
    for (int j = 0; j < 8; ++j) { const int row = chunk_row(s, c, 8 * tg + j); const size_t ro = (size_t)(row >= 0 ? row : 0) * 2048 + h * 128 + 2 * dp;
        qw[j] = *(const GAS unsigned*)(PQK + ro); kw[j] = *(const GAS unsigned*)(PQK + ro + 1024); if (row < 0) { qw[j] = 0u; kw[j] = 0u; } }
    v4u va[4];
#pragma unroll
    for (int kbi = 0; kbi < 4; ++kbi) { va[kbi] = *(const GAS v4u*)(PV + (size_t)(rowv >= 0 ? rowv : 0) * 2048 + h * 256 + 32 * ((wave & 1) * 4 + kbi) + 8 * fq); if (rowv < 0) va[kbi] = (v4u){0u, 0u, 0u, 0u}; }
    if (rowa < 0) a4 = (f32x4){0.f, 0.f, 0.f, 0.f};
    *(LAS f32x4*)(sA + (tid >> 3) * 32 + (tid & 7) * 4) = a4;
    __syncthreads();
    f32x2v lf[8], lb[8];
#pragma unroll
    for (int zz = 0; zz < 2; ++zz) {
        f32x2v w[16];
#pragma unroll
        for (int i = 0; i < 16; ++i) w[i] = *(const GAS f32x2v*)(wg2 + zz * 16384 + (size_t)i * 1024 + h * 128 + 2 * dp);
        const f32x2v bw = *(const GAS f32x2v*)(bg2 + zz * 1024 + h * 128 + 2 * dp);
#pragma unroll
        for (int j = 0; j < 8; ++j) { const int i = 8 * tg + j; const bool padtok = (c == 0 && i < 48);
            f32x2v x = bw;
#pragma unroll
            for (int k4 = 0; k4 < 4; ++k4) { const f32x4 a = *(const LAS f32x4*)(sA + i * 32 + 16 * zz + 4 * k4);
                x += w[4 * k4] * a.x + w[4 * k4 + 1] * a.y + w[4 * k4 + 2] * a.z + w[4 * k4 + 3] * a.w; }
            const f32x2v l = (f32x2v){padtok ? 0.f : logsig16(x.x), padtok ? 0.f : logsig16(x.y)};
            if (zz == 0) lf[j] = l; else lb[j] = l; }
    }
#pragma unroll
    for (int j = 1; j < 8; ++j) lf[j] += lf[j - 1];
#pragma unroll
    for (int j = 6; j >= 0; --j) lb[j] += lb[j + 1];
    *(LAS f32x2v*)(sT + tg * 128 + 2 * dp) = lf[7];
    *(LAS f32x2v*)(sT + 1024 + tg * 128 + 2 * dp) = lb[0];
    __syncthreads();
    f32x2v offf = (f32x2v){0.f, 0.f}, offb = offf, allf = offf, allb = offf;
#pragma unroll
    for (int g = 0; g < 8; ++g) { const f32x2v tf = *(const LAS f32x2v*)(sT + g * 128 + 2 * dp), tb2 = *(const LAS f32x2v*)(sT + 1024 + g * 128 + 2 * dp);
        allf += tf; allb += tb2; if (g < tg) offf += tf; if (g > tg) offb += tb2; }
    const size_t ib = (size_t)it * 8192, zb = (size_t)NITEM * 8192;
    bf16 *QTf = QT + ib, *QTb = QT + zb + ib, *KTf = KT + ib, *KTb = KT + zb + ib, *KHf = KH + ib, *KHb = KH + zb + ib;
    const float qs = 0.08838834764831845f;
    const f32x2v eaf = (f32x2v){fexp(allf.x), fexp(allf.y)}, eab = (f32x2v){fexp(allb.x), fexp(allb.y)};
    unsigned khf0[4], khf1[4], khb0[4], khb1[4];
    float pf0 = 0.f, pf1 = 0.f, pb0 = 0.f, pb1 = 0.f;
#pragma unroll
    for (int j = 0; j < 8; ++j) { const int i = 8 * tg + j;
        const float q0 = bflo(qw[j]) * qs, q1 = bfhi(qw[j]) * qs, k0 = bflo(kw[j]), k1 = bfhi(kw[j]);
        const f32x2v Bp = offf + lf[j], Bs = offb + lb[j];
        const float ef0 = fexp(Bp.x), ef1 = fexp(Bp.y), eb0 = fexp(Bs.x), eb1 = fexp(Bs.y);
        const float rf0 = __builtin_amdgcn_rcpf(ef0), rf1 = __builtin_amdgcn_rcpf(ef1), rb0 = __builtin_amdgcn_rcpf(eb0), rb1 = __builtin_amdgcn_rcpf(eb1);
        if (PVAR != 1) { *(GAS unsigned*)(QTf + i * 128 + 2 * dp) = cvtpk(q0 * ef0, q1 * ef1);
        *(GAS unsigned*)(QTb + i * 128 + 2 * dp) = cvtpk(q0 * eb0, q1 * eb1); } else { asm volatile("" :: "v"(q0 * ef0), "v"(q1 * ef1), "v"(q0 * eb0), "v"(q1 * eb1)); }
        const float ktf0 = k0 * rf0, ktf1 = k1 * rf1, ktb0 = k0 * rb0, ktb1 = k1 * rb1;
        if (PVAR != 1) { *(GAS unsigned*)(KTf + i * 128 + 2 * dp) = cvtpk(ktf0, ktf1);
        *(GAS unsigned*)(KTb + i * 128 + 2 * dp) = cvtpk(ktb0, ktb1); }
        const float hf0 = ktf0 * eaf.x, hf1 = ktf1 * eaf.y, hb0 = ktb0 * eab.x, hb1 = ktb1 * eab.y;
        if (j & 1) { khf0[j >> 1] = cvtpk(pf0, hf0); khf1[j >> 1] = cvtpk(pf1, hf1); khb0[j >> 1] = cvtpk(pb0, hb0); khb1[j >> 1] = cvtpk(pb1, hb1); }
        else { pf0 = hf0; pf1 = hf1; pb0 = hb0; pb1 = hb1; } }
    LAS unsigned char* sKf = lds + 16384; LAS unsigned char* sKb = lds + 34816; LAS unsigned char* sV = lds + 53248;
    *(LAS v4u*)(sKf + (2 * dp) * 144 + 16 * tg) = (v4u){khf0[0], khf0[1], khf0[2], khf0[3]};
    *(LAS v4u*)(sKf + (2 * dp + 1) * 144 + 16 * tg) = (v4u){khf1[0], khf1[1], khf1[2], khf1[3]};
    *(LAS v4u*)(sKb + (2 * dp) * 144 + 16 * tg) = (v4u){khb0[0], khb0[1], khb0[2], khb0[3]};
    *(LAS v4u*)(sKb + (2 * dp + 1) * 144 + 16 * tg) = (v4u){khb1[0], khb1[1], khb1[2], khb1[3]};
    if (tg == 0) { *(GAS f32x2v*)(ED + (size_t)it * 128 + 2 * dp) = eaf;
                   *(GAS f32x2v*)(ED + (size_t)(NITEM + it) * 128 + 2 * dp) = eab; }
    { short e0[8], e1[8];
#pragma unroll
      for (int j = 0; j < 8; ++j) { e0[j] = (8 * fq + j == fr) ? (short)0x3F80 : (short)0; e1[j] = (8 * fq + j == fr + 16) ? (short)0x3F80 : (short)0; }
      const bf16x8 sel0 = (bf16x8){e0[0], e0[1], e0[2], e0[3], e0[4], e0[5], e0[6], e0[7]}, sel1 = (bf16x8){e1[0], e1[1], e1[2], e1[3], e1[4], e1[5], e1[6], e1[7]};
      bf16* vt = VT + (size_t)it * 16384;
#pragma unroll
      for (int kbi = 0; kbi < 4; ++kbi) { const int kb = (wave & 1) * 4 + kbi;
          const bf16x8 A = __builtin_bit_cast(bf16x8, va[kbi]);
          const f32x4 d0 = __builtin_amdgcn_mfma_f32_16x16x32_bf16(A, sel0, (f32x4){0.f, 0.f, 0.f, 0.f}, 0, 0, 0), d1 = __builtin_amdgcn_mfma_f32_16x16x32_bf16(A, sel1, (f32x4){0.f, 0.f, 0.f, 0.f}, 0, 0, 0);
          *(LAS u32x2v*)(sV + (32 * kb + fr) * 144 + (16 * tb + 4 * fq) * 2) = (u32x2v){cvtpk(d0[0], d0[1]), cvtpk(d0[2], d0[3])};
          *(LAS u32x2v*)(sV + (32 * kb + 16 + fr) * 144 + (16 * tb + 4 * fq) * 2) = (u32x2v){cvtpk(d1[0], d1[1]), cvtpk(d1[2], d1[3])}; }
      __syncthreads();
#pragma unroll
      for (int i = 0; i < 2; ++i) { const int q = tid + 512 * i, o = (q >> 3) * 144 + (q & 7) * 16;
          ((GAS v4u*)KHf)[q] = *(const LAS v4u*)(sKf + o); ((GAS v4u*)KHb)[q] = *(const LAS v4u*)(sKb + o); }
#pragma unroll
      for (int i = 0; i < 4; ++i) { const int q = tid + 512 * i; ((GAS v4u*)vt)[q] = *(const LAS v4u*)(sV + (q >> 3) * 144 + (q & 7) * 16); } }
}
__device__ __forceinline__ void load_m8(const bf16* PC, int row, int ch0, float (&m)[8]) {
    const v4u a = *(const GAS v4u*)(PC + (size_t)row * 4096 + 2048 + ch0);
    m[0] = bflo(a.x); m[1] = bfhi(a.x); m[2] = bflo(a.y); m[3] = bfhi(a.y); m[4] = bflo(a.z); m[5] = bfhi(a.z); m[6] = bflo(a.w); m[7] = bfhi(a.w);
}
constexpr int NCONV = 2 * 257 + 4 * 129;
__device__ __forceinline__ void conv_item(int ci, const bf16* PC, const float* cw, bf16* MIX, int tid) {
    asm volatile("" : "+v"(tid));
    int s, blk; if (ci < 514) { s = ci >= 257 ? 1 : 0; blk = ci - s * 257; } else { const int j = ci - 514; s = 2 + j / 129; blk = j - (s - 2) * 129; }
    const int np = seq_len(s) + 16, ch0 = 8 * (tid & 255), p0 = 16 * blk + 8 * (tid >> 8);
    float m[10][8]; v4u cbw[8];
#pragma unroll
    for (int j = 0; j < 10; ++j) { const int p = p0 - 1 + j;
        if (p >= 0 && p < np) load_m8(PC, pos_row(s, p), ch0, m[j]);
        else {
#pragma unroll
            for (int e = 0; e < 8; ++e) m[j][e] = 0.f; } }
#pragma unroll
    for (int j = 0; j < 8; ++j) cbw[j] = *(const GAS v4u*)(PC + (size_t)pos_row(s, p0 + j) * 4096 + ch0);
    float w0[8], w1[8], w2[8];
#pragma unroll
    for (int e = 0; e < 8; ++e) { w0[e] = cw[ch0 + e]; w1[e] = cw[2048 + ch0 + e]; w2[e] = cw[4096 + ch0 + e]; }
#pragma unroll
    for (int j = 0; j < 8; ++j) { const v4u c4 = cbw[j];
        const float cbv[8] = {bflo(c4.x), bfhi(c4.x), bflo(c4.y), bfhi(c4.y), bflo(c4.z), bfhi(c4.z), bflo(c4.w), bfhi(c4.w)};
        float o[8];
#pragma unroll
        for (int e = 0; e < 8; ++e) o[e] = cbv[e] * (w0[e] * m[j][e] + w1[e] * m[j + 1][e] + w2[e] * m[j + 2][e]);
        v4u ow; ow.x = cvtpk(o[0], o[1]); ow.y = cvtpk(o[2], o[3]); ow.z = cvtpk(o[4], o[5]); ow.w = cvtpk(o[6], o[7]);
        *(GAS v4u*)(MIX + (size_t)pos_row(s, p0 + j) * 4096 + 2048 + ch0) = ow; }
}

#ifndef SCAN_DIST
#define SCAN_DIST 2
#endif
constexpr int SC_BUF = 51712, SC_KT = 16384, SC_KH = 32768, SC_ED = 51200, SC_P = 2 * SC_BUF;
__device__ __forceinline__ bf16x8 mk8(unsigned a, unsigned b, unsigned c, unsigned d) { const v4u t = (v4u){a, b, c, d}; return __builtin_bit_cast(bf16x8, t); }
struct ScanRegs { v4u q[2], k[2], h[2], v[2]; f32x4 ed; };
template <int SVAR> __device__ __forceinline__ void scan_item(int idx, LAS unsigned char* lds, const bf16* QT, const bf16* KT, const bf16* KH, const float* ED, const bf16* VT, bf16* O2, int tid, int wave, int lane) {
    int s, rem; if (idx < 64) { s = idx >> 5; rem = idx & 31; } else { s = 2 + ((idx - 64) >> 5); rem = (idx - 64) & 31; }
    const int h = rem >> 2, z = (rem >> 1) & 1, vh = rem & 1;
    const int nc = seq_nchunks(s), cbase = seq_chunkbase(s);
    const int fr = lane & 15, fq = lane >> 4;
    const int vrow = vh * 128 + 16 * wave + fr;
    const int ocol = h * 256 + vh * 128 + 16 * wave + 4 * fq;
    f32x4 Sacc[8];
#pragma unroll
    for (int i = 0; i < 8; ++i) Sacc[i] = (f32x4){0.f, 0.f, 0.f, 0.f};
    ScanRegs RA, RB; bf16x8 vcur[2];
    RA.ed = (f32x4){0.f, 0.f, 0.f, 0.f}; RB.ed = RA.ed;
#define SC_CH(st_) (z ? nc - 1 - (st_) : (st_))
#define SC_LOAD(R_, c_) do { const int it_ = (cbase + (c_)) * 8 + h; const size_t ib_ = ((size_t)z * NITEM + it_) * 8192; \
        _Pragma("unroll") for (int i_ = 0; i_ < 2; ++i_) { R_.q[i_] = ((const GAS v4u*)(QT + ib_))[tid + 512 * i_]; R_.k[i_] = ((const GAS v4u*)(KT + ib_))[tid + 512 * i_]; R_.h[i_] = ((const GAS v4u*)(KH + ib_))[tid + 512 * i_]; \
            R_.v[i_] = *(const GAS v4u*)(VT + (size_t)it_ * 16384 + (size_t)vrow * 64 + 32 * i_ + 8 * fq); } \
        R_.ed = ((const GAS f32x4*)(ED + ((size_t)z * NITEM + it_) * 128))[tid & 31]; } while (0)
#define SC_WRITE(R_, b_) do { LAS unsigned char* bb_ = lds + (b_) * SC_BUF; \
        _Pragma("unroll") for (int i_ = 0; i_ < 2; ++i_) { const int q_ = tid + 512 * i_; const int r_ = q_ >> 4, c_ = q_ & 15; const int o_ = r_ * 256 + ((c_ ^ (r_ & 15)) << 4); \
            *(LAS v4u*)(bb_ + o_) = R_.q[i_]; *(LAS v4u*)(bb_ + SC_KT + o_) = R_.k[i_]; *(LAS v4u*)(bb_ + SC_KH + (q_ >> 3) * 144 + (q_ & 7) * 16) = R_.h[i_]; } \
        if (tid < 32) *(LAS f32x4*)(bb_ + SC_ED + tid * 16) = R_.ed; \
        vcur[0] = __builtin_bit_cast(bf16x8, R_.v[0]); vcur[1] = __builtin_bit_cast(bf16x8, R_.v[1]); } while (0)
#define SC_STEP(step_, b_, RL_, RW_, DIST_, LAST_) do { const int c = SC_CH(step_); \
        LAS unsigned char* QTb = lds + (b_) * SC_BUF; LAS unsigned char* KTb = QTb + SC_KT; LAS unsigned char* KHb = QTb + SC_KH; LAS unsigned char* EDb = QTb + SC_ED; LAS unsigned char* Pb = lds + SC_P; \
        if (!(LAST_) && SVAR != 1) { const int sl_ = (step_) + (DIST_) < nc ? (step_) + (DIST_) : nc - 1; SC_LOAD(RL_, SC_CH(sl_)); }     \
          \
        _Pragma("unroll") for (int e2 = 0; e2 < 2; ++e2) { const int e = 2 * wave + e2, si = e >> 2, ti = e & 3; \
            f32x4 a4 = (f32x4){0.f, 0.f, 0.f, 0.f}; \
            _Pragma("unroll") for (int kk = 0; kk < 4; ++kk) { const int off = (((4 * kk + fq) ^ fr) << 4); \
                const bf16x8 A = *(const LAS bf16x8*)(KTb + (16 * si + fr) * 256 + off), B = *(const LAS bf16x8*)(QTb + (16 * ti + fr) * 256 + off); \
                a4 = __builtin_amdgcn_mfma_f32_16x16x32_bf16(A, B, a4, 0, 0, 0); } \
            const int tg_ = 16 * ti + fr, sg0 = 16 * si + 4 * fq; float p[4]; \
            _Pragma("unroll") for (int r = 0; r < 4; ++r) { const int sg = sg0 + r; const bool keep = z ? (sg > tg_) : (sg <= tg_); p[r] = keep ? a4[r] : 0.f; } \
            *(LAS u32x2v*)(Pb + tg_ * 144 + sg0 * 2) = (u32x2v){cvtpk(p[0], p[1]), cvtpk(p[2], p[3])}; } \
          \
        f32x4 oacc[4]; \
        _Pragma("unroll") for (int ti = 0; ti < 4; ++ti) oacc[ti] = (f32x4){0.f, 0.f, 0.f, 0.f}; \
        _Pragma("unroll") for (int kk = 0; kk < 4; ++kk) { \
            const bf16x8 Sb = mk8(cvtpk(Sacc[2 * kk][0], Sacc[2 * kk][1]), cvtpk(Sacc[2 * kk][2], Sacc[2 * kk][3]), cvtpk(Sacc[2 * kk + 1][0], Sacc[2 * kk + 1][1]), cvtpk(Sacc[2 * kk + 1][2], Sacc[2 * kk + 1][3])); \
            _Pragma("unroll") for (int ti = 0; ti < 4; ++ti) { const LAS unsigned char* rp = QTb + (16 * ti + fr) * 256 + (fq & 1) * 8; \
                const u32x2v lo = *(const LAS u32x2v*)(rp + (((4 * kk + (fq >> 1)) ^ fr) << 4)), hi = *(const LAS u32x2v*)(rp + (((4 * kk + 2 + (fq >> 1)) ^ fr) << 4)); \
                oacc[ti] = __builtin_amdgcn_mfma_f32_16x16x32_bf16(Sb, mk8(lo.x, lo.y, hi.x, hi.y), oacc[ti], 0, 0, 0); } } \
        __syncthreads();                                \
          \
        _Pragma("unroll") for (int ti = 0; ti < 4; ++ti) \
            _Pragma("unroll") for (int kk = 0; kk < 2; ++kk) { const bf16x8 Bp = *(const LAS bf16x8*)(Pb + (16 * ti + fr) * 144 + (32 * kk + 8 * fq) * 2); \
                oacc[ti] = __builtin_amdgcn_mfma_f32_16x16x32_bf16(vcur[kk], Bp, oacc[ti], 0, 0, 0); } \
          \
        _Pragma("unroll") for (int ti = 0; ti < 4; ++ti) { int row = chunk_row(s, c, 16 * ti + fr); row = row >= 0 ? row : MP - 1;     \
            if (SVAR == 0) *(GAS u32x2v*)(O2 + ((size_t)z * MP + row) * 2048 + ocol) = (u32x2v){cvtpk(oacc[ti][0], oacc[ti][1]), cvtpk(oacc[ti][2], oacc[ti][3])}; else asm volatile("" :: "v"(oacc[ti])); } \
          \
        _Pragma("unroll") for (int i8 = 0; i8 < 8; ++i8) { const f32x4 ed4 = *(const LAS f32x4*)(EDb + (16 * i8 + 4 * fq) * 4); Sacc[i8] = Sacc[i8] * ed4; \
            _Pragma("unroll") for (int kk = 0; kk < 2; ++kk) { const bf16x8 A = *(const LAS bf16x8*)(KHb + (16 * i8 + fr) * 144 + (32 * kk + 8 * fq) * 2); \
                Sacc[i8] = __builtin_amdgcn_mfma_f32_16x16x32_bf16(A, vcur[kk], Sacc[i8], 0, 0, 0); } } \
        if (!(LAST_) && SVAR != 1) SC_WRITE(RW_, (b_) ^ 1); \
        __syncthreads(); } while (0)
    SC_LOAD(RA, SC_CH(0)); SC_WRITE(RA, 0);
#if SCAN_DIST == 2
    SC_LOAD(RB, SC_CH(1));
    __syncthreads();
    for (int step = 0; step + 1 < nc; step += 2) {
        SC_STEP(step, 0, RA, RB, 2, false);
        SC_STEP(step + 1, 1, RB, RA, 2, false);
    }
    SC_STEP(nc - 1, 0, RA, RB, 2, true);
#else
    __syncthreads();
    for (int step = 0; step + 1 < nc; step += 2) {
        SC_STEP(step, 0, RA, RA, 1, false);
        SC_STEP(step + 1, 1, RA, RA, 1, false);
    }
    SC_STEP(nc - 1, 0, RA, RA, 1, true);
#endif
#undef SC_CH
#undef SC_LOAD
#undef SC_WRITE
#undef SC_STEP
}

__device__ __forceinline__ void fixup_item(int q, const float* EP, const float* EG, const float* EU, const float* EGM, const float* fw, bf16* H) {
    const int er = q / 1376, cg = q - er * 1376, pm = er >> 1, e = er & 1, f0 = 8 * cg;
    const int s = pm < 32 ? (pm >> 4) : 2 + ((pm - 32) >> 3);
    const bool first = pm < 32 ? ((pm & 15) == 0) : (((pm - 32) & 7) == 0), last = pm < 32 ? ((pm & 15) == 15) : (((pm - 32) & 7) == 7);
    const size_t eo = ((size_t)pm * 2 + e) * DFF + f0;
    f32x4 nb0 = (f32x4){0.f, 0.f, 0.f, 0.f}, nb1 = nb0, wv0, wv1;
    if (e == 0) { const float* gsrc = first ? EGM + (size_t)s * DFF + f0 : EG + ((size_t)(pm - 1) * 2 + 1) * DFF + f0; nb0 = *(const GAS f32x4*)gsrc; nb1 = *(const GAS f32x4*)(gsrc + 4);
                  wv0 = *(const GAS f32x4*)(fw + f0); wv1 = *(const GAS f32x4*)(fw + f0 + 4); }
    else { if (!last) { const float* gsrc = EG + ((size_t)(pm + 1) * 2) * DFF + f0; nb0 = *(const GAS f32x4*)gsrc; nb1 = *(const GAS f32x4*)(gsrc + 4); }
           wv0 = *(const GAS f32x4*)(fw + 2 * DFF + f0); wv1 = *(const GAS f32x4*)(fw + 2 * DFF + f0 + 4); }
    const f32x4 p0 = *(const GAS f32x4*)(EP + eo) + wv0 * nb0, p1 = *(const GAS f32x4*)(EP + eo + 4) + wv1 * nb1;
    const f32x4 u0 = *(const GAS f32x4*)(EU + eo), u1 = *(const GAS f32x4*)(EU + eo + 4);
    float o[8];
#pragma unroll
    for (int j = 0; j < 4; ++j) { o[j] = p0[j] * __builtin_amdgcn_rcpf(1.0f + __builtin_amdgcn_exp2f(-1.4426950408889634f * p0[j])) * u0[j];
                                  o[4 + j] = p1[j] * __builtin_amdgcn_rcpf(1.0f + __builtin_amdgcn_exp2f(-1.4426950408889634f * p1[j])) * u1[j]; }
    v4u ow; ow.x = cvtpk(o[0], o[1]); ow.y = cvtpk(o[2], o[3]); ow.z = cvtpk(o[4], o[5]); ow.w = cvtpk(o[6], o[7]);
    *(GAS v4u*)(H + (size_t)(pm * 256 + (e ? 255 : 0)) * DFF + f0) = ow;
}

__device__ __forceinline__ f32x4 thin_tile(const bf16* arow, const bf16* brow, int fq) {
    f32x4 acc = (f32x4){0.f, 0.f, 0.f, 0.f};
    for (int kb = 0; kb < 8; ++kb) {
        v4u a[16], bb[16];
#pragma unroll
        for (int i = 0; i < 16; ++i) { a[i] = *(const GAS v4u*)(arow + kb * 512 + 32 * i + 8 * fq); bb[i] = *(const GAS v4u*)(brow + kb * 512 + 32 * i + 8 * fq); }
#pragma unroll
        for (int i = 0; i < 16; ++i) acc = __builtin_amdgcn_mfma_f32_16x16x32_bf16(__builtin_bit_cast(bf16x8, a[i]), __builtin_bit_cast(bf16x8, bb[i]), acc, 0, 0, 0);
    }
    return acc;
}

__device__ __forceinline__ pg8::i32x4 thin_tile_i8(const unsigned char* arow, const unsigned char* brow, int fq) {
    pg8::i32x4 acc = (pg8::i32x4){0, 0, 0, 0};
    for (int kb = 0; kb < 4; ++kb) {
        v4u a[16], bb[16];
#pragma unroll
        for (int i = 0; i < 16; ++i) { a[i] = *(const GAS v4u*)(arow + kb * 1024 + 64 * i + 16 * fq); bb[i] = *(const GAS v4u*)(brow + kb * 1024 + 64 * i + 16 * fq); }
#pragma unroll
        for (int i = 0; i < 16; ++i) acc = __builtin_amdgcn_mfma_i32_16x16x64_i8(__builtin_bit_cast(pg8::i32x4, a[i]), __builtin_bit_cast(pg8::i32x4, bb[i]), acc, 0, 0, 0);
    }
    return acc;
}

struct Args { const float* in[16]; float* out; unsigned char* ws; int ph_lo, ph_hi; };
__global__ void __launch_bounds__(NWAVES * 64, 2) fwd(Args args) {
    extern __shared__ __attribute__((aligned(16))) unsigned char lds_raw[];
    LAS unsigned char* lds = (LAS unsigned char*)lds_raw;
    volatile LAS unsigned* MISC = (volatile LAS unsigned*)(lds + MISC_OFF);
    const int tid = threadIdx.x, lane = tid & 63, wave = __builtin_amdgcn_readfirstlane(tid >> 6);
    const int G = gridDim.x, bid = blockIdx.x;
    const int gw = bid * NWAVES + wave, NGW = G * NWAVES;
    unsigned char* ws = args.ws;
    gu32* ctl = (gu32*)(ws + WS_CTL);
    const float *x_prompt = args.in[0], *x_sample = args.in[1], *meta = args.in[2], *mix_g = args.in[3], *w_in = args.in[4], *wg2 = args.in[5], *bg2 = args.in[6], *hng = args.in[7],
                *cmw = args.in[8], *w_out = args.in[9], *ffn_g = args.in[10], *w_up = args.in[11], *fcw = args.in[12], *fcb = args.in[13], *w_down = args.in[14], *fin_g = args.in[15];
    float* out = args.out;
    float* AD = (float*)(ws + WS_AD); float* X1M = (float*)(ws + WS_X1M);
    bf16 *WD = (bf16*)(ws + WS_WD), *WI = (bf16*)(ws + WS_WI), *WO = (bf16*)(ws + WS_WO), *XN = (bf16*)(ws + WS_XN);
    unsigned char *WU = ws + WS_WU, *XQ = ws + WS_XQ, *WI8 = ws + WS_WI; float *CMAXP = (float*)(ws + WS_CMAXP), *CS = (float*)(ws + WS_CS), *RFI = (float*)(ws + WS_RFI); float* CMI = (float*)(ctl + CW_CMI);
    bf16 *PQK = (bf16*)(ws + WS_PQK), *PC = (bf16*)(ws + WS_PC), *PV = (bf16*)(ws + WS_PV), *PR = (bf16*)(ws + WS_PR);
    bf16 *QT = (bf16*)(ws + WS_QT), *KT = (bf16*)(ws + WS_KT), *KH = (bf16*)(ws + WS_KH), *VT = (bf16*)(ws + WS_VT); float* ED = (float*)(ws + WS_ED);
    bf16 *MIX = (bf16*)(ws + WS_MIX), *O2 = (bf16*)(ws + WS_O2), *HB = (bf16*)(ws + WS_H);
    float* PART = (float*)(ws + WS_PART);
    float *EP = (float*)(ws + WS_EP), *EG = (float*)(ws + WS_EG), *EU = (float*)(ws + WS_EU), *EGM = (float*)(ws + WS_EGM), *SSQ = (float*)(ws + WS_SSQ), *RSTD = (float*)(ws + WS_RSTD);

    for (int u = tid; u < (LDS_BYTES - RING_BYTES) / 4; u += NWAVES * 64) ((LAS unsigned*)(lds + RING_BYTES))[u] = 0u;
    __syncthreads();
    const int lo = args.ph_lo, hi = args.ph_hi;
    const bool use_bar = (hi - lo) > 1;
    XcdBarrier bar; bar.bar = (unsigned*)(ctl + CW_BAR); bar.x = 0; bar.st = nullptr;
    if (use_bar) bar = xcd_barrier_post((unsigned*)(ctl + CW_BAR), MISC + 8);
#ifndef PROBE_PHASE
#define PROBE_PHASE -1
#endif
#define REP(k) for (int rep_ = 0; rep_ < ((PROBE_PHASE == (k)) ? 2 : 1); ++rep_)
#define IN(k) (lo <= (k) && (k) < hi)
#define SEAM(k) do { if (IN(k) && IN((k) + 1)) xcd_barrier(bar); } while (0)

    if (IN(0)) REP(0) {
        for (int it = gw; it < 64 * 86; it += NGW) { const int kb = it / 86, cb = it - kb * 86;
            const float* src = w_up + (size_t)(64 * kb) * NUP + 256 * cb + 4 * lane; f32x4 mx = (f32x4){0.f, 0.f, 0.f, 0.f};
#pragma unroll 1
            for (int b = 0; b < 4; ++b) { f32x4 t[16];
#pragma unroll
                for (int i = 0; i < 16; ++i) t[i] = __builtin_nontemporal_load((const GAS f32x4*)(src + (size_t)(16 * b + i) * NUP));
#pragma unroll
                for (int i = 0; i < 16; ++i) { const float gk = fabsf(ffn_g[64 * kb + 16 * b + i]);
                    mx.x = fmaxf(mx.x, fabsf(t[i].x) * gk); mx.y = fmaxf(mx.y, fabsf(t[i].y) * gk); mx.z = fmaxf(mx.z, fabsf(t[i].z) * gk); mx.w = fmaxf(mx.w, fabsf(t[i].w) * gk); } }
            *(GAS f32x4*)(CMAXP + (size_t)kb * NUP + 256 * cb + 4 * lane) = mx; }
        for (int it = gw; it < 64 * NI8T; it += NGW) { const int kb = it / NI8T, cb = it - kb * NI8T;
            const float* src = w_in + (size_t)(64 * kb) * 12320 + in_src_col(256 * cb) + 4 * lane; float m0 = 0.f, m1 = 0.f, m2 = 0.f, m3 = 0.f;
#pragma unroll 1
            for (int b = 0; b < 4; ++b) { f32x4 t[16];
#pragma unroll
                for (int i = 0; i < 16; ++i) t[i] = __builtin_nontemporal_load((const GAS f32x4*)(src + (size_t)(16 * b + i) * 12320));
#pragma unroll
                for (int i = 0; i < 16; ++i) { m0 = fmaxf(m0, fabsf(t[i].x)); m1 = fmaxf(m1, fabsf(t[i].y)); m2 = fmaxf(m2, fabsf(t[i].z)); m3 = fmaxf(m3, fabsf(t[i].w)); } }
            unsigned* cm = (unsigned*)CMI + 256 * cb + 4 * lane;
            __hip_atomic_fetch_max(cm + 0, __builtin_bit_cast(unsigned, m0), __ATOMIC_RELAXED, __HIP_MEMORY_SCOPE_AGENT); __hip_atomic_fetch_max(cm + 1, __builtin_bit_cast(unsigned, m1), __ATOMIC_RELAXED, __HIP_MEMORY_SCOPE_AGENT);
            __hip_atomic_fetch_max(cm + 2, __builtin_bit_cast(unsigned, m2), __ATOMIC_RELAXED, __HIP_MEMORY_SCOPE_AGENT); __hip_atomic_fetch_max(cm + 3, __builtin_bit_cast(unsigned, m3), __ATOMIC_RELAXED, __HIP_MEMORY_SCOPE_AGENT); }
        for (int m = gw; m < MP; m += NGW) {
            if (m < MTOK) { const float* xr = m < 8192 ? x_prompt + (size_t)m * DM : (m < 16384 ? x_sample + (size_t)(m - 8192) * DM : meta + (size_t)((m - 16384) & 15) * DM);
                norm_row_q(xr, mix_g, XN + (size_t)m * DM, XQ + (size_t)m * DM, RFI + m, lane); }
            else { GAS v4u* o = (GAS v4u*)(XN + (size_t)m * DM) + lane; GAS u32x2v* oq = (GAS u32x2v*)(XQ + (size_t)m * DM) + lane;
#pragma unroll
                for (int j = 0; j < 8; ++j) { o[64 * j] = (v4u){0u, 0u, 0u, 0u}; oq[64 * j] = (u32x2v){0u, 0u}; }
                if (lane == 0) RFI[m] = 0.f; }
        }
    }
    SEAM(0);
    if (IN(1)) REP(1) {
        LAS float* scr = (LAS float*)(lds + wave * 16384);
        { CvRegs va, vb; int it = gw;
          if (it < CV_I_I) { CvDesc da = cv_desc_in(it, w_in, ffn_g, CMI, WI); cv_load(da, va, lane);
              for (;;) { const int itb = it + NGW; CvDesc db = da; if (itb < CV_I_I) { db = cv_desc_in(itb, w_in, ffn_g, CMI, WI); cv_load(db, vb, lane); }
                  cv_finish(da, va, scr, lane); if (itb >= CV_I_I) break;
                  it = itb + NGW; if (it < CV_I_I) { da = cv_desc_in(it, w_in, ffn_g, CMI, WI); cv_load(da, va, lane); }
                  cv_finish(db, vb, scr, lane); if (it >= CV_I_I) break; } } }
    }
    SEAM(1);
    if (IN(2)) REP(2) {
        { pg8::Gemm g{(const bf16*)XQ, (const bf16*)WI8, MREAL, NI8C, DM / 2}; pg8::StaticOrder S; S.init(MREAL, NI8C, G, bid);
          pg8::EpiIn8 E{PQK, PV, PR, RFI, CMI};
          pg8::gemm_phase<pg8::EpiIn8, pg8::StaticOrder, true, true, 0, true>(lds, g, S, E); }
        __syncthreads();
        { pg8::Gemm g{XN, WI + (size_t)NI8C * DM, MREAL, 12288 - NI8C, DM}; pg8::StaticOrder S; S.init(MREAL, 12288 - NI8C, G, bid);
          pg8::EpiIn E{PQK, PV, PR, PC, AD, NI8T};
          pg8::gemm_phase<pg8::EpiIn, pg8::StaticOrder, true, true>(lds, g, S, E); }
        { const int fr = lane & 15, fq = lane >> 4;
          for (int blk = bid; blk < MREAL / 64; blk += G) { const int r0 = 64 * blk + 16 * (wave >> 1), c0 = 16 * (wave & 1);
              const f32x4 d = thin_tile(XN + (size_t)(r0 + fr) * DM, WI + (size_t)(12288 + c0 + fr) * DM, fq);
#pragma unroll
              for (int r = 0; r < 4; ++r) AD[(size_t)(r0 + 4 * fq + r) * 32 + c0 + fr] = d[r]; }
          for (int t = gw; t < 770; t += NGW) { const int n0 = 16 * t; f32x4 d;
              const bool paired = n0 >= 8192 && n0 < 12288;
              if (paired && ((n0 - 8192) & 128)) continue;
              if (n0 < NI8C) { const pg8::i32x4 di = thin_tile_i8(XQ + (size_t)(MREAL + fr) * DM, WI8 + (size_t)(n0 + fr) * DM, fq); const float cf = CMI[n0 + fr] * (1.0f / 127.0f);
#pragma unroll
                  for (int r = 0; r < 4; ++r) d[r] = (float)di[r] * (RFI[MREAL + 4 * fq + r] * cf); }
              else d = thin_tile(XN + (size_t)(MREAL + fr) * DM, WI + (size_t)(n0 + fr) * DM, fq);
              if (paired) d = d * thin_tile(XN + (size_t)(MREAL + fr) * DM, WI + (size_t)(n0 + 128 + fr) * DM, fq);
              const int n = n0 + fr;
#pragma unroll
              for (int r = 0; r < 4; ++r) { const int i = 4 * fq + r;
                  if (n0 >= 12288) {
#pragma unroll
                      for (int s6 = 0; s6 < 6; ++s6) AD[(size_t)(MREAL + 16 * s6 + i) * 32 + (n - 12288)] = d[r]; }
                  else { bf16* base; int ldc, col; if (n0 < 2048) { base = PV; ldc = 2048; col = n; } else if (n0 < 4096) { base = PR; ldc = 2048; col = n - 2048; } else if (n0 < 6144) { base = PQK; ldc = 2048; col = n - 4096; } else if (n0 < 8192) { base = PC; ldc = 4096; col = n - 6144; } else { base = PC; ldc = 4096; col = 2048 + 128 * ((n0 - 8192) >> 8) + ((n0 - 8192) & 127) + fr; }
                      const unsigned short hv = (unsigned short)(cvtpk(d[r], 0.f) & 0xffffu);
#pragma unroll
                      for (int s6 = 0; s6 < 6; ++s6) base[(size_t)(MREAL + 16 * s6 + i) * ldc + col] = hv; } } } }
    }
    SEAM(2);
    if (IN(3)) REP(3) {
        for (int n = bid * 512 + tid; n < NUP; n += G * 512) { float m = 0.f;
#pragma unroll 8
            for (int kb = 0; kb < 64; ++kb) m = fmaxf(m, CMAXP[(size_t)kb * NUP + n]);
            CS[n] = m * (1.0f / 127.0f); }
        for (int it = bid; it < NITEM + NCONV; it += G) {
            if (it < NITEM) prep_item<0>(it, lds, AD, PQK, PV, wg2, bg2, QT, KT, KH, ED, VT, tid, wave, lane);
            else conv_item(it - NITEM, PC, cmw, MIX, tid);
        }
#if PROBE_PHASE == 21
        for (int it = NITEM + bid; it < NITEM + NCONV; it += G) conv_item(it - NITEM, PC, cmw, MIX, tid);
#elif PROBE_PHASE >= 22 && PROBE_PHASE <= 29
        for (int it = bid; it < NITEM; it += G) prep_item<PROBE_PHASE - 22>(it, lds, AD, PQK, PV, wg2, bg2, QT, KT, KH, ED, VT, tid, wave, lane);
#endif
    }
    SEAM(3);
    if (IN(4)) REP(4) {
        for (int it = bid; it < 192; it += G) scan_item<0>(it, lds, QT, KT, KH, ED, VT, O2, tid, wave, lane);
        { LAS float* scr = (LAS float*)(lds + wave * 16384); CvRegs va, vb, vc, vd;
          for (;;) { int base = 0; if (lane == 0) base = (int)__hip_atomic_fetch_add(ctl + CW_Q, 16u, __ATOMIC_RELAXED, __HIP_MEMORY_SCOPE_AGENT);
              base = __builtin_amdgcn_readfirstlane(base); if (base >= CV_I_REST) break;
              CvDesc da = cv_desc_rest(base, w_out, w_up, w_down, ffn_g, CS, WO, WU, WD), db = cv_desc_rest(base + 1, w_out, w_up, w_down, ffn_g, CS, WO, WU, WD), dc = cv_desc_rest(base + 2, w_out, w_up, w_down, ffn_g, CS, WO, WU, WD), dd = cv_desc_rest(base + 3, w_out, w_up, w_down, ffn_g, CS, WO, WU, WD);
              cv_load(da, va, lane); cv_load(db, vb, lane); cv_load(dc, vc, lane); cv_load(dd, vd, lane);
              for (int it = base; it < base + 16; it += 4) { const bool more = it + 4 < base + 16;
                  cv_finish(da, va, scr, lane); if (more) { da = cv_desc_rest(it + 4, w_out, w_up, w_down, ffn_g, CS, WO, WU, WD); cv_load(da, va, lane); }
                  cv_finish(db, vb, scr, lane); if (more) { db = cv_desc_rest(it + 5, w_out, w_up, w_down, ffn_g, CS, WO, WU, WD); cv_load(db, vb, lane); }
                  cv_finish(dc, vc, scr, lane); if (more) { dc = cv_desc_rest(it + 6, w_out, w_up, w_down, ffn_g, CS, WO, WU, WD); cv_load(dc, vc, lane); }
                  cv_finish(dd, vd, scr, lane); if (more) { dd = cv_desc_rest(it + 7, w_out, w_up, w_down, ffn_g, CS, WO, WU, WD); cv_load(dd, vd, lane); } } } }
    }
    SEAM(4);
    if (IN(5)) REP(5) {
        const f32x4 g4 = *(const GAS f32x4*)(hng + 4 * lane);
        for (int wi = gw; wi < MTOK * 8; wi += NGW) { const int row = wi >> 3, h = wi & 7;
            const u32x2v a = *(const GAS u32x2v*)(O2 + (size_t)row * 2048 + h * 256 + 4 * lane), b = *(const GAS u32x2v*)(O2 + ((size_t)MP + row) * 2048 + h * 256 + 4 * lane);
            const u32x2v rw = *(const GAS u32x2v*)(PR + (size_t)row * 2048 + h * 256 + 4 * lane);
            const float o0 = bflo(a.x) + bflo(b.x), o1 = bfhi(a.x) + bfhi(b.x), o2 = bflo(a.y) + bflo(b.y), o3 = bfhi(a.y) + bfhi(b.y);
            const float rs = 1.0f / sqrtf(wave_sum((o0 * o0 + o1 * o1) + (o2 * o2 + o3 * o3)) * (1.0f / 256.0f) + EPS);
            const float r0 = bflo(rw.x), r1 = bfhi(rw.x), r2 = bflo(rw.y), r3 = bfhi(rw.y);
            const float y0 = o0 * rs * g4.x * (r0 / (1.0f + expf(-r0))), y1 = o1 * rs * g4.y * (r1 / (1.0f + expf(-r1))), y2 = o2 * rs * g4.z * (r2 / (1.0f + expf(-r2))), y3 = o3 * rs * g4.w * (r3 / (1.0f + expf(-r3)));
            *(GAS u32x2v*)(MIX + (size_t)row * 4096 + h * 256 + 4 * lane) = (u32x2v){cvtpk(y0, y1), cvtpk(y2, y3)}; }
    }
    SEAM(5);
    if (IN(6)) REP(6) {
        pg8::Gemm g{MIX, WO, MREAL, DM, DM}; pg8::StaticOrder S; S.init(MREAL, DM, G, bid);
        pg8::EpiOut E{x_prompt, x_sample, XN, SSQ};
        pg8::gemm_phase<pg8::EpiOut, pg8::StaticOrder, true, true>(lds, g, S, E);
        __syncthreads();
        pg8::Gemm g2{MIX, WO, MP, DM, 256, DM}; pg8::MiniOrder S2{64, 16, 16, G, bid};
        pg8::EpiPart E2{PART};
        pg8::gemm_phase<pg8::EpiPart, pg8::MiniOrder, true, true>(lds, g2, S2, E2);
    }
    SEAM(6);
    if (IN(7)) REP(7) {
        for (int m = gw; m < MREAL; m += NGW) {
            const float sv = SSQ[(size_t)m * 64 + lane]; v4u w[8];
#pragma unroll
            for (int j = 0; j < 8; ++j) w[j] = *(const GAS v4u*)(XN + (size_t)m * DM + 8 * lane + 512 * j);
            const float rstd = 1.0f / sqrtf(wave_sum(sv) * (1.0f / 4096.0f) + EPS);
            float amax = 0.f;
#pragma unroll
            for (int j = 0; j < 8; ++j) { amax = fmaxf(amax, fmaxf(fmaxf(fabsf(bflo(w[j].x)), fabsf(bfhi(w[j].x))), fmaxf(fabsf(bflo(w[j].y)), fabsf(bfhi(w[j].y)))));
                                          amax = fmaxf(amax, fmaxf(fmaxf(fabsf(bflo(w[j].z)), fabsf(bfhi(w[j].z))), fmaxf(fabsf(bflo(w[j].w)), fabsf(bfhi(w[j].w))))); }
            amax = wave_max(amax); const float sc = amax > 0.f ? 127.0f / amax : 0.f;
#pragma unroll
            for (int j = 0; j < 8; ++j) { u32x2v o; o.x = q8x4(bflo(w[j].x) * sc, bfhi(w[j].x) * sc, bflo(w[j].y) * sc, bfhi(w[j].y) * sc); o.y = q8x4(bflo(w[j].z) * sc, bfhi(w[j].z) * sc, bflo(w[j].w) * sc, bfhi(w[j].w) * sc);
                *(GAS u32x2v*)(XQ + (size_t)m * DM + 8 * lane + 512 * j) = o; }
            if (lane == 0) RSTD[m] = amax * (1.0f / 127.0f) * rstd;
        }
        for (int m = MREAL + gw; m < MP; m += NGW) {
            if (m < MTOK) { const int r = m - MREAL; float ss = 0.f, amax = 0.f;
#pragma unroll 2
                for (int j = 0; j < 8; ++j) { const int col = 8 * lane + 512 * j; const GAS f32x4* mp = (const GAS f32x4*)(meta + (size_t)(r & 15) * DM + col); f32x4 a = mp[0], b = mp[1];
#pragma unroll
                    for (int ks = 0; ks < 16; ++ks) { const GAS f32x4* pp = (const GAS f32x4*)(PART + ((size_t)ks * 96 + r) * DM + col); a += pp[0]; b += pp[1]; }
                    GAS f32x4* xo = (GAS f32x4*)(X1M + (size_t)r * DM + col); xo[0] = a; xo[1] = b;
                    ss += (a.x * a.x + a.y * a.y) + (a.z * a.z + a.w * a.w) + (b.x * b.x + b.y * b.y) + (b.z * b.z + b.w * b.w);
                    v4u o; o.x = cvtpk(a.x, a.y); o.y = cvtpk(a.z, a.w); o.z = cvtpk(b.x, b.y); o.w = cvtpk(b.z, b.w); *(GAS v4u*)(XN + (size_t)m * DM + col) = o;
                    amax = fmaxf(amax, fmaxf(fmaxf(fabsf(bflo(o.x)), fabsf(bfhi(o.x))), fmaxf(fabsf(bflo(o.y)), fabsf(bfhi(o.y)))));
                    amax = fmaxf(amax, fmaxf(fmaxf(fabsf(bflo(o.z)), fabsf(bfhi(o.z))), fmaxf(fabsf(bflo(o.w)), fabsf(bfhi(o.w))))); }
                const float rr = 1.0f / sqrtf(wave_sum(ss) * (1.0f / 4096.0f) + EPS);
                amax = wave_max(amax); const float sc = amax > 0.f ? 127.0f / amax : 0.f;
#pragma unroll 2
                for (int j = 0; j < 8; ++j) { const int col = 8 * lane + 512 * j; const v4u w = *(const GAS v4u*)(XN + (size_t)m * DM + col);
                    u32x2v o; o.x = q8x4(bflo(w.x) * sc, bfhi(w.x) * sc, bflo(w.y) * sc, bfhi(w.y) * sc); o.y = q8x4(bflo(w.z) * sc, bfhi(w.z) * sc, bflo(w.w) * sc, bfhi(w.w) * sc);
                    *(GAS u32x2v*)(XQ + (size_t)m * DM + col) = o; }
                if (lane == 0) RSTD[m] = amax * (1.0f / 127.0f) * rr; }
            else {
#pragma unroll
                for (int j = 0; j < 8; ++j) *(GAS u32x2v*)(XQ + (size_t)m * DM + 8 * lane + 512 * j) = (u32x2v){0u, 0u};
                if (lane == 0) RSTD[m] = 0.f; }
        }
    }
    SEAM(7);
    if (IN(8)) REP(8) {
        pg8::Gemm g{(const bf16*)XQ, (const bf16*)WU, MP, NUP, DM / 2}; pg8::StaticOrder S; S.init(MP, NUP, G, bid);
        pg8::EpiUpFused E{HB, RSTD, CS, fcw, fcb, EP, EG, EU, EGM, (LAS float*)(lds + RING_BYTES + 4096)};
        pg8::gemm_phase<pg8::EpiUpFused, pg8::StaticOrder, true, true, 0, true>(lds, g, S, E);
#if PROBE_PHASE >= 70 && PROBE_PHASE <= 89
        { pg8::EpiNull EN; pg8::gemm_phase<pg8::EpiNull, pg8::StaticOrder, true, true, PROBE_PHASE - 70>(lds, g, S, EN); }
#endif
    }
    SEAM(8);
    if (IN(9)) REP(9) {
        for (int q = bid * 512 + tid; q < 128 * 1376; q += G * 512) fixup_item(q, EP, EG, EU, EGM, fcw, HB);
    }
    SEAM(9);
    if (IN(10)) REP(10) {
        pg8::Gemm g{HB, WD, MREAL, DM, DFF}; pg8::StaticOrder S; S.init(MREAL, DM, G, bid);
        pg8::EpiDown E{XN};
        pg8::gemm_phase<pg8::EpiDown, pg8::StaticOrder, true, true>(lds, g, S, E);
    }
    SEAM(10);
    if (IN(11)) REP(11) {
        for (int m = gw; m < MREAL; m += NGW) {
            float v[8][8]; float s = 0.f;
#pragma unroll
            for (int j = 0; j < 8; ++j) { const v4u w = *(const GAS v4u*)(XN + (size_t)m * DM + 8 * lane + 512 * j);
                v[j][0] = bflo(w.x); v[j][1] = bfhi(w.x); v[j][2] = bflo(w.y); v[j][3] = bfhi(w.y); v[j][4] = bflo(w.z); v[j][5] = bfhi(w.z); v[j][6] = bflo(w.w); v[j][7] = bfhi(w.w);
#pragma unroll
                for (int e = 0; e < 8; ++e) s += v[j][e] * v[j][e]; }
            const float rstd = 1.0f / sqrtf(wave_sum(s) * (1.0f / 4096.0f) + EPS);
#pragma unroll
            for (int j = 0; j < 8; ++j) { const GAS f32x4* gp = (const GAS f32x4*)(fin_g + 8 * lane + 512 * j); const f32x4 g0 = gp[0], g1 = gp[1];
                GAS f32x4* op = (GAS f32x4*)(out + (size_t)m * DM + 8 * lane + 512 * j);
                op[0] = (f32x4){v[j][0] * rstd * g0.x, v[j][1] * rstd * g0.y, v[j][2] * rstd * g0.z, v[j][3] * rstd * g0.w};
                op[1] = (f32x4){v[j][4] * rstd * g1.x, v[j][5] * rstd * g1.y, v[j][6] * rstd * g1.z, v[j][7] * rstd * g1.w}; } }
    }
#undef IN
#undef SEAM
}

extern "C" void kernel_launch(void* const* d_in, const int* in_sizes, int n_in, void* d_out, int out_size, void* d_ws, size_t ws_size, hipStream_t stream) {
    static int grid = 0;
    if (grid == 0) {
        if (n_in != 16 || ws_size < WS_END) { fprintf(stderr, "kernel_launch: unexpected n_in %d / ws_size %zu (need %zu)\n", n_in, ws_size, (size_t)WS_END); grid = -1; return; }
        int dev = 0, cus = 0, per_cu = 0;
        if (hipGetDevice(&dev) != hipSuccess || hipDeviceGetAttribute(&cus, hipDeviceAttributeMultiprocessorCount, dev) != hipSuccess) { grid = -1; return; }
        if (hipFuncSetAttribute((const void*)fwd, hipFuncAttributeMaxDynamicSharedMemorySize, LDS_BYTES) != hipSuccess) { fprintf(stderr, "kernel_launch: hipFuncSetAttribute failed\n"); grid = -1; return; }
        if (hipOccupancyMaxActiveBlocksPerMultiprocessor(&per_cu, (const void*)fwd, NWAVES * 64, LDS_BYTES) != hipSuccess || per_cu < 1) { fprintf(stderr, "kernel_launch: occupancy query says %d\n", per_cu); }
        (void)hipGetLastError();
        grid = cus;
    }
    if (grid < 0) return;
    (void)hipMemsetAsync((char*)d_ws + WS_CTL, 0, CTL_ZERO_BYTES, stream);
    Args a{};
    for (int i = 0; i < 16; ++i) a.in[i] = (const float*)d_in[i];
    a.out = (float*)d_out; a.ws = (unsigned char*)d_ws;
#if MK_ONE_LAUNCH
    a.ph_lo = 0; a.ph_hi = NPHASE;
    hipLaunchKernelGGL(fwd, dim3(grid), dim3(NWAVES * 64), LDS_BYTES, stream, a);
#else
    for (int p = 0; p < NPHASE; ++p) { a.ph_lo = p; a.ph_hi = p + 1; hipLaunchKernelGGL(fwd, dim3(grid), dim3(NWAVES * 64), LDS_BYTES, stream, a); }
#endif
}
```

```cpp
#include <hip/hip_runtime.h>
#include <cstdio>
#include <cstdint>
namespace pg8 {
#define PG8_LAS __attribute__((address_space(3)))
typedef unsigned short bf16_t;
typedef short bf16x8 __attribute__((ext_vector_type(8)));
typedef float f32x4 __attribute__((ext_vector_type(4)));
typedef unsigned u32x4 __attribute__((ext_vector_type(4)));
typedef unsigned u32x2 __attribute__((ext_vector_type(2)));
typedef int i32x4 __attribute__((ext_vector_type(4)));
constexpr int BM = 256, BK = 64, HALF = 128, HTB = HALF * BK * 2  , STAGE_BYTES = 8 * HTB, NXCD = 8, WGM = 8;

__host__ __device__ __forceinline__ int lds_byte(int r, int c) { const int st = (r >> 4) * 2 + (c >> 5), rr = r & 15, cc = c & 31, ob = rr * 64 + cc * 2; return st * 1024 + (ob ^ (((ob >> 9) & 1) << 5)); }
__host__ __device__ __forceinline__ void stage_rc(int b, int& R, int& C) { const int st = b / 1024, sb = b % 1024, swz = sb ^ (((sb >> 9) & 1) << 5); R = (st >> 1) * 16 + swz / 64; C = (st & 1) * 32 + (swz % 64) / 2; }
__host__ __device__ __forceinline__ int perm32(int rho) { const int n = rho >> 4, i = rho & 15; return 8 * (i >> 2) + 4 * n + (i & 3); }

struct Unit { int pm, pn; int ks = 0; };
struct Gemm { const bf16_t* A; const bf16_t* Bt; int M, N, K; int ld = 0; };

struct StaticOrder {
    int nM, nN, nwg, G, c;
    __host__ __device__ void init(int M, int N, int G_, int c_) { nM = M / BM; nN = N / BM; nwg = nM * nN; G = G_; c = c_; }
    __host__ __device__ bool next(int i, Unit& u) const {
        const long L = (long)i * G + c; if (L >= nwg) return false;
        int wgid = (int)L; { const int q = nwg / NXCD, r = nwg % NXCD, xcd = wgid % NXCD, off = wgid / NXCD; wgid = (xcd < r ? xcd * (q + 1) : r * (q + 1) + (xcd - r) * q) + off; }
        const int nig = WGM * nN, gid = wgid / nig, fm = gid * WGM, gsz = (nM - fm) < WGM ? (nM - fm) : WGM;
        u.pm = fm + ((wgid % nig) % gsz); u.pn = (wgid % nig) / gsz; return true;
    }
    __device__ __forceinline__ void a_ready(const Unit&) const {}
    __device__ __forceinline__ void done(const Unit&) const {}
};

typedef float f32x2_t __attribute__((ext_vector_type(2))); typedef __bf16 bf16x2_t __attribute__((ext_vector_type(2)));
__device__ __forceinline__ unsigned cvt_pk_bf16(float lo, float hi) { const f32x2_t v = {lo, hi}; const bf16x2_t b = __builtin_convertvector(v, bf16x2_t); return __builtin_bit_cast(unsigned, b); }
typedef float f32x2 __attribute__((ext_vector_type(2)));
struct EpiIn {
    static constexpr bool PERM = true, AFTER_DRAIN = false;
    bf16_t *PQK, *PV, *PR, *PC; float* AD; int pn_off;
    __device__ __forceinline__ void operator()(const f32x4 (&acc)[2][2][4][2], const Unit& u, int wr, int wc, int fr, int fq) const {
        const int row0 = u.pm * BM + wr * 64 + fr; const int pn = u.pn + pn_off;
        if (pn < 32) {
            bf16_t* base; int ldc, colt;
            if (pn < 8) { base = PV; ldc = 2048; colt = pn * 256; }
            else if (pn < 16) { base = PR; ldc = 2048; colt = (pn - 8) * 256; }
            else if (pn < 24) { base = PQK; ldc = 2048; colt = (pn - 16) * 256; }
            else { base = PC; ldc = 4096; colt = (pn - 24) * 256; }
            const int col0 = colt + wc * 32 + 8 * fq;
#pragma unroll
            for (int ai = 0; ai < 2; ++ai)
#pragma unroll
                for (int m = 0; m < 4; ++m) { bf16_t* rowp = base + (size_t)(row0 + ai * HALF + m * 16) * ldc + col0;
#pragma unroll
                    for (int bj = 0; bj < 2; ++bj) { const f32x4 v0 = acc[ai][bj][m][0], v1 = acc[ai][bj][m][1];
                        u32x4 w; w.x = cvt_pk_bf16(v0[0], v0[1]); w.y = cvt_pk_bf16(v0[2], v0[3]); w.z = cvt_pk_bf16(v1[0], v1[1]); w.w = cvt_pk_bf16(v1[2], v1[3]);
                        *(u32x4*)(rowp + bj * HALF) = w; } }
        } else if (pn < 48) {
            const int col0 = 2048 + (pn - 32) * 128 + wc * 32 + 8 * fq;
#pragma unroll
            for (int ai = 0; ai < 2; ++ai)
#pragma unroll
                for (int m = 0; m < 4; ++m) { bf16_t* rowp = PC + (size_t)(row0 + ai * HALF + m * 16) * 4096 + col0;
                    const f32x4 v0 = acc[ai][0][m][0] * acc[ai][1][m][0], v1 = acc[ai][0][m][1] * acc[ai][1][m][1];
                    u32x4 w; w.x = cvt_pk_bf16(v0[0], v0[1]); w.y = cvt_pk_bf16(v0[2], v0[3]); w.z = cvt_pk_bf16(v1[0], v1[1]); w.w = cvt_pk_bf16(v1[2], v1[3]);
                    *(u32x4*)rowp = w; }
        } else if (wc == 0) {
#pragma unroll
            for (int ai = 0; ai < 2; ++ai)
#pragma unroll
                for (int m = 0; m < 4; ++m) { float* rowp = AD + (size_t)(row0 + ai * HALF + m * 16) * 32 + 8 * fq;
#pragma unroll
                    for (int n = 0; n < 2; ++n) *(f32x4*)(rowp + 4 * n) = acc[ai][0][m][n]; }
        }
    }
};
struct EpiIn8 {
    static constexpr bool PERM = true, AFTER_DRAIN = false;
    bf16_t *PQK, *PV, *PR; const float* RF; const float* CM;
    __device__ __forceinline__ void operator()(const f32x4 (&acc)[2][2][4][2], const Unit& u, int wr, int wc, int fr, int fq) const {
        const int row0 = u.pm * BM + wr * 64 + fr; const int pn = u.pn;
        bf16_t* base; int colt;
        if (pn < 8) { base = PV; colt = pn * 256; } else if (pn < 16) { base = PR; colt = (pn - 8) * 256; } else { base = PQK; colt = (pn - 16) * 256; }
        const int col0 = colt + wc * 32 + 8 * fq;
        f32x4 cf[2][2];
#pragma unroll
        for (int bj = 0; bj < 2; ++bj)
#pragma unroll
            for (int n = 0; n < 2; ++n) cf[bj][n] = *(const f32x4*)(CM + pn * 256 + bj * HALF + wc * 32 + 8 * fq + 4 * n) * (1.0f / 127.0f);
#pragma unroll
        for (int ai = 0; ai < 2; ++ai)
#pragma unroll
            for (int m = 0; m < 4; ++m) { const int row = row0 + ai * HALF + m * 16; const float rf = RF[row]; bf16_t* rowp = base + (size_t)row * 2048 + col0;
#pragma unroll
                for (int bj = 0; bj < 2; ++bj) { const f32x4 v0 = __builtin_convertvector(__builtin_bit_cast(i32x4, acc[ai][bj][m][0]), f32x4) * (cf[bj][0] * rf), v1 = __builtin_convertvector(__builtin_bit_cast(i32x4, acc[ai][bj][m][1]), f32x4) * (cf[bj][1] * rf);
                    u32x4 w; w.x = cvt_pk_bf16(v0[0], v0[1]); w.y = cvt_pk_bf16(v0[2], v0[3]); w.z = cvt_pk_bf16(v1[0], v1[1]); w.w = cvt_pk_bf16(v1[2], v1[3]);
                    *(u32x4*)(rowp + bj * HALF) = w; } }
    }
};
struct EpiBf16Plain {
    static constexpr bool PERM = true, AFTER_DRAIN = false;
    bf16_t* O; int ldc;
    __device__ __forceinline__ void operator()(const f32x4 (&acc)[2][2][4][2], const Unit& u, int wr, int wc, int fr, int fq) const {
        const int row0 = u.pm * BM + wr * 64 + fr, col0 = u.pn * BM + wc * 32 + 8 * fq;
#pragma unroll
        for (int ai = 0; ai < 2; ++ai)
#pragma unroll
            for (int m = 0; m < 4; ++m) { bf16_t* rowp = O + (size_t)(row0 + ai * HALF + m * 16) * ldc + col0;
#pragma unroll
                for (int bj = 0; bj < 2; ++bj) { const f32x4 v0 = acc[ai][bj][m][0], v1 = acc[ai][bj][m][1];
                    u32x4 w; w.x = cvt_pk_bf16(v0[0], v0[1]); w.y = cvt_pk_bf16(v0[2], v0[3]); w.z = cvt_pk_bf16(v1[0], v1[1]); w.w = cvt_pk_bf16(v1[2], v1[3]);
                    *(u32x4*)(rowp + bj * HALF) = w; } }
    }
};
struct EpiOut {
    static constexpr bool PERM = false, AFTER_DRAIN = false;
    const float *xp, *xs; bf16_t* XN; float* SSQ;
    __device__ __forceinline__ void operator()(f32x4 (&acc)[2][2][4][2], const Unit& u, int wr, int wc, int fr, int fq) const {
        const int row0 = u.pm * BM + wr * 64 + fr, col0 = u.pn * BM + wc * 32 + 4 * fq;
#pragma unroll
        for (int ai = 0; ai < 2; ++ai)
#pragma unroll
            for (int m = 0; m < 4; ++m) { const int row = row0 + ai * HALF + m * 16; float ss = 0.f;
                const float* src = row < 8192 ? xp + (size_t)row * 4096 : xs + (size_t)(row - 8192) * 4096; bf16_t* xb = XN + (size_t)row * 4096;
#pragma unroll
                for (int bj = 0; bj < 2; ++bj)
#pragma unroll
                    for (int n = 0; n < 2; ++n) { const int off = col0 + bj * HALF + n * 16; const f32x4 v = *(const f32x4*)(src + off) + acc[ai][bj][m][n];
                        ss += (v[0] * v[0] + v[1] * v[1]) + (v[2] * v[2] + v[3] * v[3]);
                        u32x2 w; w.x = cvt_pk_bf16(v[0], v[1]); w.y = cvt_pk_bf16(v[2], v[3]); *(u32x2*)(xb + off) = w; }
                ss += __shfl_xor(ss, 16); ss += __shfl_xor(ss, 32);
                if (fq == 0) SSQ[(size_t)row * 64 + u.pn * 4 + wc] = ss; }
    }
};
struct EpiPart {
    static constexpr bool PERM = false, AFTER_DRAIN = false;
    float* PART;
    __device__ __forceinline__ void operator()(f32x4 (&acc)[2][2][4][2], const Unit& u, int wr, int wc, int fr, int fq) const {
        const int col0 = u.pn * BM + wc * 32 + 4 * fq;
#pragma unroll
        for (int m = 0; m < 4; ++m) { const int row = wr * 64 + m * 16 + fr;
            if (row < 96) { float* dst = PART + ((size_t)u.ks * 96 + row) * 4096 + col0;
#pragma unroll
                for (int bj = 0; bj < 2; ++bj)
#pragma unroll
                    for (int n = 0; n < 2; ++n) *(f32x4*)(dst + bj * HALF + n * 16) = acc[0][bj][m][n]; } }
    }
};
struct MiniOrder {
    int pm, ncol, nks, G, c;
    __device__ bool next(int i, Unit& u) const { const int j = i * G + c; if (j >= ncol * nks) return false; u.pm = pm; u.pn = j % ncol; u.ks = j / ncol; return true; }
    __device__ __forceinline__ void a_ready(const Unit&) const {}
    __device__ __forceinline__ void done(const Unit&) const {}
};
struct EpiDown {
    static constexpr bool PERM = false, AFTER_DRAIN = false;
    bf16_t* X;
    __device__ __forceinline__ void operator()(f32x4 (&acc)[2][2][4][2], const Unit& u, int wr, int wc, int fr, int fq) const {
        const int row0 = u.pm * BM + wr * 64 + fr, col0 = u.pn * BM + wc * 32 + 4 * fq;
#pragma unroll
        for (int ai = 0; ai < 2; ++ai)
#pragma unroll
            for (int m = 0; m < 4; ++m) { bf16_t* rowp = X + (size_t)(row0 + ai * HALF + m * 16) * 4096 + col0;
#pragma unroll
                for (int bj = 0; bj < 2; ++bj)
#pragma unroll
                    for (int n = 0; n < 2; ++n) { bf16_t* p = rowp + bj * HALF + n * 16; const u32x2 w = *(const u32x2*)p; const f32x4 a = acc[ai][bj][m][n];
                        u32x2 o; o.x = cvt_pk_bf16(__builtin_bit_cast(float, w.x << 16) + a[0], __builtin_bit_cast(float, w.x & 0xffff0000u) + a[1]);
                        o.y = cvt_pk_bf16(__builtin_bit_cast(float, w.y << 16) + a[2], __builtin_bit_cast(float, w.y & 0xffff0000u) + a[3]); *(u32x2*)p = o; } }
    }
};

struct EpiNull {
    static constexpr bool PERM = true, AFTER_DRAIN = false;
    __device__ __forceinline__ void operator()(const f32x4 (&acc)[2][2][4][2], const Unit& u, int wr, int wc, int fr, int fq) const {
#pragma unroll
        for (int ai = 0; ai < 2; ++ai)
#pragma unroll
            for (int bj = 0; bj < 2; ++bj)
#pragma unroll
                for (int m = 0; m < 4; ++m)
#pragma unroll
                    for (int n = 0; n < 2; ++n) asm volatile("" :: "v"(acc[ai][bj][m][n]));
    }
};
struct EpiUpFused {
    static constexpr bool PERM = true, AFTER_DRAIN = false;
    bf16_t* H; const float* RSTD; const float* CS; const float* cw; const float* cb; float *EP, *EG, *EU, *EGM; PG8_LAS float* halo;
    __device__ __forceinline__ void operator()(f32x4 (&acc)[2][2][4][2], const Unit& u, int wr, int wc, int fr, int fq) const {
        const int lane = fq * 16 + fr, ft = wc * 32 + 8 * fq, f0 = u.pn * 128 + ft;
        float rs[2][4]; f32x4 su[2], sg[2];
#pragma unroll
        for (int ai = 0; ai < 2; ++ai)
#pragma unroll
            for (int m = 0; m < 4; ++m) rs[ai][m] = RSTD[u.pm * BM + ai * HALF + wr * 64 + m * 16 + fr];
#pragma unroll
        for (int n = 0; n < 2; ++n) { su[n] = *(const f32x4*)(CS + f0 + 4 * n); sg[n] = *(const f32x4*)(CS + 11008 + f0 + 4 * n); }
#pragma unroll
        for (int ai = 0; ai < 2; ++ai)
#pragma unroll
            for (int m = 0; m < 4; ++m)
#pragma unroll
                for (int n = 0; n < 2; ++n) {
                    acc[ai][1][m][n] = __builtin_convertvector(__builtin_bit_cast(i32x4, acc[ai][1][m][n]), f32x4) * (sg[n] * rs[ai][m]);
                    acc[ai][0][m][n] = __builtin_convertvector(__builtin_bit_cast(i32x4, acc[ai][0][m][n]), f32x4) * (su[n] * rs[ai][m]); }
        if (fr == 0) {
#pragma unroll
            for (int ai = 0; ai < 2; ++ai)
#pragma unroll
                for (int n = 0; n < 2; ++n) *(PG8_LAS f32x4*)(halo + (2 * ai + wr) * 128 + ft + 4 * n) = acc[ai][1][0][n]; }
        if (fr == 15) {
#pragma unroll
            for (int ai = 0; ai < 2; ++ai)
#pragma unroll
                for (int n = 0; n < 2; ++n) *(PG8_LAS f32x4*)(halo + (4 + 2 * ai + wr) * 128 + ft + 4 * n) = acc[ai][1][3][n]; }
        asm volatile("s_waitcnt lgkmcnt(0)" ::: "memory"); __builtin_amdgcn_s_barrier(); asm volatile("" ::: "memory");
        f32x4 w0[2], w1[2], w2[2], bb[2];
#pragma unroll
        for (int n = 0; n < 2; ++n) { w0[n] = *(const f32x4*)(cw + f0 + 4 * n); w1[n] = *(const f32x4*)(cw + 11008 + f0 + 4 * n); w2[n] = *(const f32x4*)(cw + 22016 + f0 + 4 * n); bb[n] = *(const f32x4*)(cb + f0 + 4 * n); }
        const int srcp = (lane & 48) | ((lane - 1) & 15), srcn = (lane & 48) | ((lane + 1) & 15);
        const bool meta_tile = (u.pm == 64);
#pragma unroll
        for (int ai = 0; ai < 2; ++ai) {
            f32x4 hp[2], hn[2];
            const bool has_p = !(ai == 0 && wr == 0), has_n = !(ai == 1 && wr == 1);
            const int sp = (wr == 1) ? 4 + 2 * ai : 4 + 1, sn = (wr == 0) ? 2 * ai + 1 : 2;
#pragma unroll
            for (int n = 0; n < 2; ++n) { hp[n] = has_p ? *(const PG8_LAS f32x4*)(halo + sp * 128 + ft + 4 * n) : (f32x4){0.f, 0.f, 0.f, 0.f};
                                          hn[n] = has_n ? *(const PG8_LAS f32x4*)(halo + sn * 128 + ft + 4 * n) : (f32x4){0.f, 0.f, 0.f, 0.f}; }
#pragma unroll
            for (int m = 0; m < 4; ++m) { const int rl = ai * HALF + wr * 64 + m * 16 + fr;
                f32x4 hv[2], gcs[2];
#pragma unroll
                for (int n = 0; n < 2; ++n) { const f32x4 gc = acc[ai][1][m][n]; gcs[n] = gc;
                    f32x4 tp = gc, tn = gc;
                    if (m > 0) { if (fr == 15) tp = acc[ai][1][m - 1][n]; }
                    if (m < 3) { if (fr == 0) tn = acc[ai][1][m + 1][n]; }
                    f32x4 gp, gn;
#pragma unroll
                    for (int j = 0; j < 4; ++j) { gp[j] = __shfl(tp[j], srcp); gn[j] = __shfl(tn[j], srcn); }
                    if (m == 0) { if (fr == 0) gp = hp[n]; }
                    if (m == 3) { if (fr == 15) gn = hn[n]; }
                    const f32x4 pre = w0[n] * gp + w1[n] * gc + w2[n] * gn + bb[n];
                    hv[n] = pre; }
                const bool edge0 = (rl == 0), edge1 = (rl == 255);
                if (meta_tile) {
                    if (ai == 0 && fr == 15 && rl < 96) { float* d = EGM + (size_t)(rl >> 4) * 11008 + f0; *(f32x4*)d = gcs[0]; *(f32x4*)(d + 4) = gcs[1]; }
                } else if (edge0 || edge1) { const size_t eo = ((size_t)u.pm * 2 + (edge1 ? 1 : 0)) * 11008 + f0;
                    *(f32x4*)(EP + eo) = hv[0]; *(f32x4*)(EP + eo + 4) = hv[1]; *(f32x4*)(EG + eo) = gcs[0]; *(f32x4*)(EG + eo + 4) = gcs[1];
                    *(f32x4*)(EU + eo) = acc[ai][0][m][0]; *(f32x4*)(EU + eo + 4) = acc[ai][0][m][1];
                } else { float o[8];
#pragma unroll
                    for (int n = 0; n < 2; ++n)
#pragma unroll
                        for (int j = 0; j < 4; ++j) { const float p = hv[n][j]; o[4 * n + j] = p * __builtin_amdgcn_rcpf(1.0f + __builtin_amdgcn_exp2f(-1.4426950408889634f * p)) * acc[ai][0][m][n][j]; }
                    u32x4 w; w.x = cvt_pk_bf16(o[0], o[1]); w.y = cvt_pk_bf16(o[2], o[3]); w.z = cvt_pk_bf16(o[4], o[5]); w.w = cvt_pk_bf16(o[6], o[7]);
                    *(u32x4*)(H + (size_t)(u.pm * BM + rl) * 11008 + f0) = w; } } }
    }
};
template <bool I8> __device__ __forceinline__ f32x4 mma16(const bf16x8 b, const bf16x8 a, const f32x4 c) {
    if constexpr (I8) return __builtin_bit_cast(f32x4, __builtin_amdgcn_mfma_i32_16x16x64_i8(__builtin_bit_cast(i32x4, b), __builtin_bit_cast(i32x4, a), __builtin_bit_cast(i32x4, c), 0, 0, 0));
    else return __builtin_amdgcn_mfma_f32_16x16x32_bf16(b, a, c, 0, 0, 0);
}
template <class Epi, class Sched, bool ALIGN_EPI = false, bool SP2 = false, int VAR = 0, bool I8 = false>
__device__ __forceinline__ void gemm_phase(PG8_LAS unsigned char* lds, const Gemm g, const Sched& S, const Epi& E) {
    const int tid = threadIdx.x, wid = __builtin_amdgcn_readfirstlane(tid >> 6), lane = tid & 63, wr = wid >> 2, wc = wid & 3, fr = lane & 15, fq = lane >> 4;
    const int K = g.K, nt = K / BK, ld = g.ld ? g.ld : g.K;
    unsigned voffA[2], voffB[2];
#pragma unroll
    for (int i = 0; i < 2; ++i) { int R, C; stage_rc(tid * 16 + i * 8192, R, C); const int Rb = Epi::PERM ? ((R & ~31) + perm32(R & 31)) : R;
        voffA[i] = (unsigned)(R * ld + C) * 2u; voffB[i] = (unsigned)(Rb * ld + C) * 2u; }
    const size_t kstep = (VAR == 1) ? (size_t)0 : (size_t)(BK * 2);
    const size_t hstep = (size_t)HALF * ld * 2;
    const size_t tstep = 2 * hstep;
    const unsigned ldsw = (unsigned)wid * 1024u;
    const int aoff = (VAR == 6) ? lane * 16 : lds_byte(wr * 64 + fr, fq * 8), boff = (VAR == 6) ? lane * 16 : lds_byte(wc * 32 + fr, fq * 8);
#define PG8_SA(b, h) (((b) * 2 + (h)) * HTB)
#define PG8_SB(b, h) ((4 + (b) * 2 + (h)) * HTB)
#define PG8_STAGE(bufoff, gbase, voff) do { if (VAR != 3 && VAR != 4) _Pragma("unroll") for (int _i = 0; _i < 2; ++_i) \
        __builtin_amdgcn_global_load_lds((const unsigned*)((const char*)(gbase) + (voff)[_i]), (PG8_LAS unsigned*)(lds + (bufoff) + ldsw + _i * 8192), 16, 0, 0); } while (0)
#define PG8_LDA(dst, b, h) do { if (VAR != 4) _Pragma("unroll") for (int m = 0; m < 4; ++m) _Pragma("unroll") for (int k = 0; k < 2; ++k) dst[m][k] = *(const PG8_LAS bf16x8*)(lds + PG8_SA(b, h) + aoff + m * 2048 + k * 1024); } while (0)
#define PG8_LDB(dst, b, h) do { if (VAR != 4) _Pragma("unroll") for (int n = 0; n < 2; ++n) _Pragma("unroll") for (int k = 0; k < 2; ++k) dst[n][k] = *(const PG8_LAS bf16x8*)(lds + PG8_SB(b, h) + boff + n * 2048 + k * 1024); } while (0)
#define PG8_MMA(ai, bj, At, Bt) do { if (VAR == 11) __builtin_amdgcn_s_setprio(3); else if (VAR != 8 && VAR != 9) __builtin_amdgcn_s_setprio(1); if (VAR != 2) _Pragma("unroll") for (int m = 0; m < 4; ++m) _Pragma("unroll") for (int n = 0; n < 2; ++n) _Pragma("unroll") for (int k = 0; k < 2; ++k) \
        acc[ai][bj][m][n] = mma16<I8>(Bt[n][k], At[m][k], acc[ai][bj][m][n]); if (VAR == 10) __builtin_amdgcn_s_setprio(2); else if (VAR == 11) __builtin_amdgcn_s_setprio(1); else if (VAR != 8 && VAR != 9) __builtin_amdgcn_s_setprio(0); } while (0)
#define PG8_WAIT_V(n) asm volatile("s_waitcnt vmcnt(" #n ")" ::: "memory")
#define PG8_WAIT_L(n) asm volatile("s_waitcnt lgkmcnt(" #n ")" ::: "memory")
#define PG8_BAR __builtin_amdgcn_s_barrier()
#define PG8_SCHED __builtin_amdgcn_sched_barrier(0)
    Unit cur, nxt; int ui = 0;
    if (VAR == 9) { if (wr == 1) __builtin_amdgcn_s_setprio(1); }
    if (!S.next(0, cur)) return;
    f32x4 acc[2][2][4][2];
#pragma unroll
    for (int a = 0; a < 2; ++a)
#pragma unroll
        for (int b = 0; b < 2; ++b)
#pragma unroll
            for (int m = 0; m < 4; ++m)
#pragma unroll
                for (int n = 0; n < 2; ++n) acc[a][b][m][n] = (f32x4){0.f, 0.f, 0.f, 0.f};
    bf16x8 At[4][2], B0[2][2], B1[2][2];
    if (VAR == 4) { const short sv = (short)(0x3c00 + tid);
#pragma unroll
        for (int m = 0; m < 4; ++m) for (int k = 0; k < 2; ++k) { At[m][k] = (bf16x8){sv, sv, sv, sv, sv, sv, sv, sv}; asm volatile("" : "+v"(At[m][k])); }
#pragma unroll
        for (int n = 0; n < 2; ++n) for (int k = 0; k < 2; ++k) { B0[n][k] = (bf16x8){sv, sv, sv, sv, sv, sv, sv, sv}; B1[n][k] = B0[n][k]; asm volatile("" : "+v"(B0[n][k])); asm volatile("" : "+v"(B1[n][k])); } }
    const char* cA = (const char*)g.A + (size_t)cur.pm * tstep + (size_t)cur.ks * K * 2; const char* cB = (const char*)g.Bt + (size_t)cur.pn * tstep + (size_t)cur.ks * K * 2;
    S.a_ready(cur);
    if constexpr (SP2) {
        PG8_STAGE(PG8_SB(0, 0), cB, voffB); PG8_STAGE(PG8_SB(0, 1), cB + hstep, voffB); PG8_STAGE(PG8_SA(0, 0), cA, voffA); PG8_STAGE(PG8_SA(0, 1), cA + hstep, voffA);
        if (wr == 1) PG8_BAR;
        PG8_WAIT_V(2); PG8_BAR;
        PG8_STAGE(PG8_SB(1, 0), cB + kstep, voffB); PG8_STAGE(PG8_SA(1, 0), cA + kstep, voffA); PG8_STAGE(PG8_SB(1, 1), cB + hstep + kstep, voffB);
        PG8_WAIT_V(6); PG8_BAR;
    } else {
        PG8_STAGE(PG8_SB(0, 0), cB, voffB); PG8_STAGE(PG8_SA(0, 0), cA, voffA); PG8_STAGE(PG8_SB(0, 1), cB + hstep, voffB); PG8_STAGE(PG8_SA(0, 1), cA + hstep, voffA);
        if (wr == 1) PG8_BAR;
        PG8_WAIT_V(4); PG8_BAR;
        PG8_STAGE(PG8_SB(1, 0), cB + kstep, voffB); PG8_STAGE(PG8_SA(1, 0), cA + kstep, voffA); PG8_STAGE(PG8_SB(1, 1), cB + hstep + kstep, voffB);
        PG8_WAIT_V(6); PG8_BAR;
    }
    for (;;) {
        const bool has_next = S.next(ui + 1, nxt);
        const char* nA = has_next ? (const char*)g.A + (size_t)nxt.pm * tstep + (size_t)nxt.ks * K * 2 : cA; const char* nB = has_next ? (const char*)g.Bt + (size_t)nxt.pn * tstep + (size_t)nxt.ks * K * 2 : cB;
        for (int t = 0; t < nt; t += 2) {
            const bool last = (t == nt - 2);
            const char* a1 = cA + (size_t)(t + 1) * kstep;
            const char* a2 = last ? nA : cA + (size_t)(t + 2) * kstep; const char* b2 = last ? nB : cB + (size_t)(t + 2) * kstep;
            const char* a3 = a2 + kstep; const char* b3 = b2 + kstep;
            if (last && has_next) S.a_ready(nxt);
            if constexpr (SP2 && VAR == 5) {
            PG8_LDB(B0, 0, 0); PG8_LDB(B1, 0, 1); PG8_SCHED; PG8_LDA(At, 0, 0);
            PG8_WAIT_V(6); PG8_WAIT_L(0); PG8_BAR; PG8_MMA(0, 0, At, B0); PG8_SCHED; PG8_STAGE(PG8_SA(1, 1), a1 + hstep, voffA); PG8_SCHED; PG8_MMA(0, 1, At, B1); PG8_BAR; PG8_SCHED;
            PG8_LDA(At, 0, 1);
            PG8_WAIT_V(2); PG8_WAIT_L(0); PG8_BAR; PG8_MMA(1, 0, At, B0); PG8_SCHED; PG8_STAGE(PG8_SB(0, 0), b2, voffB); PG8_STAGE(PG8_SB(0, 1), b2 + hstep, voffB); PG8_STAGE(PG8_SA(0, 0), a2, voffA); PG8_SCHED; PG8_MMA(1, 1, At, B1); PG8_BAR; PG8_SCHED;
            PG8_LDB(B0, 1, 0); PG8_LDB(B1, 1, 1); PG8_SCHED; PG8_LDA(At, 1, 0);
            PG8_WAIT_V(6); PG8_WAIT_L(0); PG8_BAR; PG8_MMA(0, 0, At, B0); PG8_SCHED; PG8_STAGE(PG8_SA(0, 1), a2 + hstep, voffA); PG8_SCHED; PG8_MMA(0, 1, At, B1); PG8_BAR; PG8_SCHED;
            PG8_LDA(At, 1, 1);
            PG8_WAIT_V(2); PG8_WAIT_L(0); PG8_BAR; PG8_MMA(1, 0, At, B0); PG8_SCHED; PG8_STAGE(PG8_SB(1, 0), b3, voffB); PG8_STAGE(PG8_SB(1, 1), b3 + hstep, voffB); PG8_STAGE(PG8_SA(1, 0), a3, voffA); PG8_SCHED; PG8_MMA(1, 1, At, B1); PG8_BAR; PG8_SCHED;
            } else if constexpr (SP2) {
            PG8_LDB(B0, 0, 0); PG8_LDB(B1, 0, 1); PG8_SCHED; PG8_LDA(At, 0, 0); PG8_STAGE(PG8_SA(1, 1), a1 + hstep, voffA);
            PG8_WAIT_V(8); PG8_WAIT_L(0); PG8_BAR; PG8_MMA(0, 0, At, B0); PG8_MMA(0, 1, At, B1); PG8_BAR; PG8_SCHED;
            if (VAR != 7) PG8_LDA(At, 0, 1); PG8_STAGE(PG8_SB(0, 0), b2, voffB); PG8_STAGE(PG8_SB(0, 1), b2 + hstep, voffB); PG8_STAGE(PG8_SA(0, 0), a2, voffA);
            PG8_WAIT_V(8); PG8_WAIT_L(0); PG8_BAR; PG8_MMA(1, 0, At, B0); PG8_MMA(1, 1, At, B1); PG8_BAR; PG8_SCHED;
            PG8_LDB(B0, 1, 0); PG8_LDB(B1, 1, 1); PG8_SCHED; PG8_LDA(At, 1, 0); PG8_STAGE(PG8_SA(0, 1), a2 + hstep, voffA);
            PG8_WAIT_V(8); PG8_WAIT_L(0); PG8_BAR; PG8_MMA(0, 0, At, B0); PG8_MMA(0, 1, At, B1); PG8_BAR; PG8_SCHED;
            if (VAR != 7) PG8_LDA(At, 1, 1); PG8_STAGE(PG8_SB(1, 0), b3, voffB); PG8_STAGE(PG8_SB(1, 1), b3 + hstep, voffB); PG8_STAGE(PG8_SA(1, 0), a3, voffA);
            PG8_WAIT_V(8); PG8_WAIT_L(0); PG8_BAR; PG8_MMA(1, 0, At, B0); PG8_MMA(1, 1, At, B1); PG8_BAR; PG8_SCHED;
            } else {
            PG8_LDB(B0, 0, 0); PG8_SCHED; PG8_LDA(At, 0, 0); PG8_STAGE(PG8_SA(1, 1), a1 + hstep, voffA);
            PG8_WAIT_L(8); PG8_BAR; PG8_WAIT_L(0); PG8_MMA(0, 0, At, B0); PG8_BAR; PG8_SCHED;
            PG8_LDB(B1, 0, 1); PG8_STAGE(PG8_SB(0, 0), b2, voffB);
            PG8_BAR; PG8_WAIT_L(0); PG8_MMA(0, 1, At, B1); PG8_BAR;
            PG8_LDA(At, 0, 1); PG8_STAGE(PG8_SA(0, 0), a2, voffA);
            PG8_BAR; PG8_WAIT_L(0); PG8_MMA(1, 0, At, B0); PG8_BAR; PG8_SCHED;
            PG8_STAGE(PG8_SB(0, 1), b2 + hstep, voffB);
            PG8_WAIT_V(6); PG8_BAR; PG8_MMA(1, 1, At, B1); PG8_BAR;
            PG8_LDB(B0, 1, 0); PG8_SCHED; PG8_LDA(At, 1, 0); PG8_STAGE(PG8_SA(0, 1), a2 + hstep, voffA);
            PG8_WAIT_L(8); PG8_BAR; PG8_WAIT_L(0); PG8_MMA(0, 0, At, B0); PG8_BAR; PG8_SCHED;
            PG8_LDB(B1, 1, 1); PG8_STAGE(PG8_SB(1, 0), b3, voffB);
            PG8_BAR; PG8_WAIT_L(0); PG8_MMA(0, 1, At, B1); PG8_BAR;
            PG8_LDA(At, 1, 1); PG8_STAGE(PG8_SA(1, 0), a3, voffA);
            PG8_BAR; PG8_WAIT_L(0); PG8_MMA(1, 0, At, B0); PG8_BAR; PG8_SCHED;
            PG8_STAGE(PG8_SB(1, 1), b3 + hstep, voffB);
            PG8_WAIT_V(6); PG8_BAR; PG8_MMA(1, 1, At, B1); PG8_BAR;
            }
        }
        if constexpr (ALIGN_EPI) { if (wr == 0) PG8_BAR; }
        if constexpr (!Epi::AFTER_DRAIN) { E(acc, cur, wr, wc, fr, fq); S.done(cur); }
        if (!has_next) break;
#pragma unroll
        for (int a = 0; a < 2; ++a)
#pragma unroll
            for (int b = 0; b < 2; ++b)
#pragma unroll
                for (int m = 0; m < 4; ++m)
#pragma unroll
                    for (int n = 0; n < 2; ++n) acc[a][b][m][n] = (f32x4){0.f, 0.f, 0.f, 0.f};
        cur = nxt; cA = nA; cB = nB; ++ui;
        if constexpr (ALIGN_EPI) { if (wr == 1) PG8_BAR; }
    }
    PG8_WAIT_V(0);
    if constexpr (!ALIGN_EPI) { if (wr == 0) PG8_BAR; }
    PG8_BAR;
    if constexpr (Epi::AFTER_DRAIN) { E.fused(acc, cur, wr, wc, fr, fq, lds, wid, lane); S.done(cur); }
#undef PG8_SA
#undef PG8_SB
#undef PG8_STAGE
#undef PG8_LDA
#undef PG8_LDB
#undef PG8_MMA
#undef PG8_WAIT_V
#undef PG8_WAIT_L
#undef PG8_BAR
#undef PG8_SCHED
}
}
#define GAS __attribute__((address_space(1)))
#define LAS __attribute__((address_space(3)))
typedef unsigned short bf16;
typedef unsigned v4u __attribute__((ext_vector_type(4)));
typedef float f32x4 __attribute__((ext_vector_type(4)));
typedef short bf16x8 __attribute__((ext_vector_type(8)));
typedef GAS unsigned gu32;
typedef GAS unsigned long long gu64;
#define RLX_AGENT __ATOMIC_RELAXED, __HIP_MEMORY_SCOPE_AGENT
#define LDS_WAIT() asm volatile("s_waitcnt lgkmcnt(0)" ::: "memory")
#define VM_WAIT() asm volatile("s_waitcnt vmcnt(0)" ::: "memory")
__device__ __forceinline__ unsigned long long rt() { return __builtin_amdgcn_s_memrealtime(); }
__device__ __forceinline__ unsigned f2bf(float f) { unsigned u = __builtin_bit_cast(unsigned, f); return (u + 0x7fffu + ((u >> 16) & 1u)) >> 16; }
__device__ __forceinline__ unsigned pk2(float lo, float hi) { return f2bf(lo) | (f2bf(hi) << 16); }

#define XB_TMO      128
#define XB_XCNT(j)  (256  + 64 * (j))
#define XB_XSUB(j)  (1280 + 64 * (j))
#define XB_XGEN(j)  (2304 + 64 * (j))
#define XB_TOP      3328
#define XB_TOPGEN   3392
#define XCD_BAR_WORDS 3456
#define XB_SPIN_CAP (1u << 18)

__device__ __forceinline__ unsigned xb_ld(unsigned* p)              { return __hip_atomic_load(p, __ATOMIC_RELAXED, __HIP_MEMORY_SCOPE_AGENT); }
__device__ __forceinline__ unsigned xb_add(unsigned* p, unsigned v) { return __hip_atomic_fetch_add(p, v, __ATOMIC_RELAXED, __HIP_MEMORY_SCOPE_AGENT); }
__device__ __forceinline__ unsigned xb_xcc_id() { return (unsigned)__builtin_amdgcn_s_getreg((3 << 11) | 20) & 0xFu; }
#define XB_SPIN(cond, bar) do { unsigned _sp = 0; while (cond) { __builtin_amdgcn_s_sleep(1); \
    if ((++_sp & 255u) == 0u) { if (xb_ld(&(bar)[XB_TMO])) break; if (_sp > XB_SPIN_CAP) { atomicAdd(&(bar)[XB_TMO], 1u); break; } } } } while (0)

struct XcdBarrier {
    unsigned* bar; unsigned x;
    volatile LAS unsigned* st;
};

__device__ __forceinline__ XcdBarrier xcd_barrier_post(unsigned* bar, volatile LAS unsigned* st) {
    XcdBarrier b; b.bar = bar; b.x = xb_xcc_id(); b.st = st;
    if (threadIdx.x == 0) (void)xb_add(&bar[XB_XCNT(b.x)], 1u);
    return b;
}
__device__ __forceinline__ void xcd_barrier_complete(unsigned* bar, unsigned x, unsigned& nloc, unsigned& nx) {
    const unsigned G = gridDim.x * gridDim.y * gridDim.z;
    unsigned sum, cnt, mine, sp = 0u;
    for (;;) {
        sum = 0u; cnt = 0u; mine = 0u;
#pragma unroll
        for (unsigned j = 0; j < 16; ++j) { const unsigned c = xb_ld(&bar[XB_XCNT(j)]); sum += c; cnt += (c > 0u) ? 1u : 0u; mine = (j == x) ? c : mine; }
        if (sum == G) break;
        __builtin_amdgcn_s_sleep(1);
        if ((++sp & 255u) == 0u) { if (xb_ld(&bar[XB_TMO])) break; if (sp > XB_SPIN_CAP) { atomicAdd(&bar[XB_TMO], 1u); break; } }
    }
    nloc = mine > 0u ? mine : 1u; nx = cnt > 0u ? cnt : 1u;
}

__device__ __forceinline__ void xcd_barrier(const XcdBarrier& b) {
    asm volatile("s_waitcnt vmcnt(0)" ::: "memory");
    __syncthreads();
    if (threadIdx.x == 0) {
        unsigned* bar = b.bar;
        __builtin_amdgcn_s_waitcnt(0);
        unsigned nloc = b.st[0], nx = b.st[1];
        if (nloc == 0u) { xcd_barrier_complete(bar, b.x, nloc, nx); b.st[0] = nloc; b.st[1] = nx; }
        const unsigned old = xb_add(&bar[XB_XSUB(b.x)], 1u);
        const unsigned gen = old / nloc;
        if (old + 1u == (gen + 1u) * nloc) {
            __builtin_amdgcn_fence(__ATOMIC_RELEASE, "agent");
            asm volatile("s_waitcnt vmcnt(0)" ::: "memory");
            const unsigned og = xb_add(&bar[XB_TOP], 1u);
            const unsigned tg = og / nx;
            if (og + 1u == (tg + 1u) * nx) xb_add(&bar[XB_TOPGEN], 1u);
            else XB_SPIN(xb_ld(&bar[XB_TOPGEN]) == tg, bar);
            __builtin_amdgcn_fence(__ATOMIC_ACQUIRE, "agent");
            xb_add(&bar[XB_XGEN(b.x)], 1u);
            asm volatile("s_waitcnt vmcnt(0)" ::: "memory");
        } else {
            XB_SPIN(xb_ld(&bar[XB_XGEN(b.x)]) == gen, bar);
            __builtin_amdgcn_fence(__ATOMIC_ACQUIRE, "agent");
            asm volatile("s_waitcnt vmcnt(0)" ::: "memory");
        }
    }
    __syncthreads();
}
constexpr int NWAVES = 8;
constexpr int DM = 4096, DFF = 11008, NUP = 2 * DFF, NI = 12544;
constexpr int MREAL = 16384, MTOK = 16480, MP = 16640;
constexpr int NITEM = 2096;
constexpr int NCSEQ = 262;
constexpr float EPS = 1e-6f;
constexpr size_t MiB = 1u << 20;
constexpr size_t WS_CTL = 0, CTL_ZERO_BYTES = 65536;
constexpr size_t WS_AD = 1 * MiB;
constexpr size_t WS_X1M = 4 * MiB;
constexpr size_t WS_WD = 6 * MiB;
constexpr size_t WS_WI = 92 * MiB;
constexpr size_t WS_WO = 190 * MiB;
constexpr size_t WS_WU = 222 * MiB;
constexpr size_t WS_XQ = 308 * MiB;
constexpr size_t WS_CMAXP = 374 * MiB;
constexpr size_t WS_CS = 380 * MiB;
constexpr size_t WS_RFI = 381 * MiB;
constexpr int NI8T = 24, NI8C = NI8T * 256;
constexpr int CW_CMI = 8192;
constexpr size_t WS_XN = 394 * MiB;
constexpr size_t WS_PQK = 524 * MiB;
constexpr size_t WS_PC = 589 * MiB;
constexpr size_t WS_PV = 784 * MiB;
constexpr size_t WS_PR = 849 * MiB;
constexpr size_t WS_QT = 914 * MiB;
constexpr size_t WS_KT = 980 * MiB;
constexpr size_t WS_KH = 1046 * MiB;
constexpr size_t WS_ED = 1112 * MiB;
constexpr size_t WS_MIX = 1115 * MiB;
constexpr size_t WS_VT = 1245 * MiB;
constexpr size_t WS_END = 1335 * MiB;
constexpr size_t WS_O2 = WS_PQK;
constexpr size_t WS_H = WS_PQK;
constexpr size_t WS_EP = 870 * MiB, WS_EG = 876 * MiB, WS_EU = 882 * MiB;
constexpr size_t WS_EGM = 888 * MiB;
constexpr size_t WS_SSQ = 889 * MiB;
constexpr size_t WS_RSTD = 894 * MiB;
constexpr size_t WS_PART = 1311 * MiB;
static_assert(WS_H + (size_t)MREAL * DFF * 2 <= WS_EP && WS_EP + (size_t)64 * 2 * DFF * 4 <= WS_EG && WS_EGM + (size_t)6 * DFF * 4 <= WS_SSQ && WS_SSQ + (size_t)MP * 64 * 4 <= WS_RSTD && WS_RSTD + (size_t)MP * 4 <= WS_QT && WS_O2 + (size_t)2 * MP * 2048 * 2 <= WS_PV, "ws map");
static_assert(WS_QT + (size_t)2 * NITEM * 8192 * 2 <= WS_KT && WS_KH + (size_t)2 * NITEM * 8192 * 2 <= WS_ED && WS_ED + (size_t)2 * NITEM * 128 * 4 <= WS_MIX, "ws map 2");
constexpr int CW_BAR = 4096;
constexpr int CW_Q = 64;
constexpr int RING_BYTES = 131072, MISC_OFF = RING_BYTES + 320, LDS_BYTES = 147456;
constexpr int NPHASE = 12;
#ifndef MK_ONE_LAUNCH
#define MK_ONE_LAUNCH 1
#endif

typedef float f32x2v __attribute__((ext_vector_type(2)));
typedef unsigned u32x2v __attribute__((ext_vector_type(2)));

__device__ __forceinline__ float wave_sum(float v) {
#pragma unroll
    for (int o = 1; o < 64; o <<= 1) v += __shfl_xor(v, o);
    return v;
}
__device__ __forceinline__ float wave_max(float v) {
#pragma unroll
    for (int o = 1; o < 64; o <<= 1) v = fmaxf(v, __shfl_xor(v, o));
    return v;
}
__device__ __forceinline__ unsigned q8(float f) { return __builtin_bit_cast(unsigned, f + 12582912.0f) & 0xffu; }
__device__ __forceinline__ unsigned q8x4(float a, float b, float c, float d) { return q8(a) | (q8(b) << 8) | (q8(c) << 16) | (q8(d) << 24); }
__device__ __forceinline__ unsigned cvtpk(float lo, float hi) { return pg8::cvt_pk_bf16(lo, hi); }
__device__ __forceinline__ float bflo(unsigned w) { return __builtin_bit_cast(float, w << 16); }
__device__ __forceinline__ float bfhi(unsigned w) { return __builtin_bit_cast(float, w & 0xffff0000u); }
__device__ __forceinline__ float bf1(unsigned short h) { return __builtin_bit_cast(float, (unsigned)h << 16); }

__device__ __forceinline__ int seq_rowbase(int s) { return s < 2 ? s * 4096 : 8192 + (s - 2) * 2048; }
__device__ __forceinline__ int seq_len(int s) { return s < 2 ? 4096 : 2048; }
__device__ __forceinline__ int seq_nchunks(int s) { return s < 2 ? 65 : 33; }
__device__ __forceinline__ int seq_chunkbase(int s) { return s < 2 ? s * 65 : 130 + (s - 2) * 33; }
__device__ __forceinline__ void cs_decode(int cs, int& s, int& c) { if (cs < 130) { s = cs >= 65 ? 1 : 0; c = cs - s * 65; } else { const int j = cs - 130; s = 2 + j / 33; c = j - (s - 2) * 33; } }
__device__ __forceinline__ int chunk_row(int s, int c, int i) { return c == 0 ? (i < 48 ? -1 : 16384 + 16 * s + (i - 48)) : seq_rowbase(s) + 64 * (c - 1) + i; }
__device__ __forceinline__ int pos_row(int s, int p) { return p < 16 ? 16384 + 16 * s + p : seq_rowbase(s) + p - 16; }

struct CvDesc { const float* src; const float* ks; const float* cs; void* dst; int N, K, kind; };
struct CvRegs { f32x4 v[8]; float kv, cs; };
__device__ __forceinline__ void cv_load(const CvDesc& d, CvRegs& R, int lane) {
    const int kr = lane >> 3, nc4 = 4 * (lane & 7);
#pragma unroll
    for (int i = 0; i < 8; ++i) R.v[i] = __builtin_nontemporal_load((const GAS f32x4*)(d.src + (size_t)(kr + 8 * i) * d.N + nc4));
    R.kv = *(const GAS float*)(d.ks + lane);
    R.cs = *(const GAS float*)(d.cs + (lane & 31));
}
__device__ __forceinline__ void cv_finish(const CvDesc& d, CvRegs& R, LAS float* scr, int lane) {
    const int kr = lane >> 3, nc4 = 4 * (lane & 7);
#pragma unroll
    for (int i = 0; i < 8; ++i) { LAS float* p = scr + (kr + 8 * i) * 33 + nc4; p[0] = R.v[i].x; p[1] = R.v[i].y; p[2] = R.v[i].z; p[3] = R.v[i].w; }
    scr[64 * 33 + lane] = R.kv; if (lane < 32) scr[64 * 33 + 64 + lane] = R.cs;
    LDS_WAIT(); asm volatile("" ::: "memory");
    if (d.kind != 0) {
        const int c = lane & 3; const float cmul = d.kind == 2 ? (1.0f / 127.0f) : 1.0f;
        f32x4 kq[4];
#pragma unroll
        for (int i = 0; i < 4; ++i) { kq[i] = *(const LAS f32x4*)(scr + 64 * 33 + 16 * c + 4 * i); if (d.kind == 2) kq[i] = (f32x4){1.f, 1.f, 1.f, 1.f}; }
#pragma unroll
        for (int j = 0; j < 2; ++j) { const int n = (lane >> 2) + 16 * j; const LAS float* sp = scr + (16 * c) * 33 + n;
            const float cn = scr[64 * 33 + 64 + n] * cmul, inv = cn > 0.f ? __builtin_amdgcn_rcpf(cn) : 0.f;
            v4u o;
            o.x = q8x4(sp[0 * 33] * kq[0].x * inv, sp[1 * 33] * kq[0].y * inv, sp[2 * 33] * kq[0].z * inv, sp[3 * 33] * kq[0].w * inv);
            o.y = q8x4(sp[4 * 33] * kq[1].x * inv, sp[5 * 33] * kq[1].y * inv, sp[6 * 33] * kq[1].z * inv, sp[7 * 33] * kq[1].w * inv);
            o.z = q8x4(sp[8 * 33] * kq[2].x * inv, sp[9 * 33] * kq[2].y * inv, sp[10 * 33] * kq[2].z * inv, sp[11 * 33] * kq[2].w * inv);
            o.w = q8x4(sp[12 * 33] * kq[3].x * inv, sp[13 * 33] * kq[3].y * inv, sp[14 * 33] * kq[3].z * inv, sp[15 * 33] * kq[3].w * inv);
            *(GAS v4u*)((unsigned char*)d.dst + (size_t)n * d.K + 16 * c) = o; }
    } else {
        const int c = lane & 7;
#pragma unroll
        for (int j = 0; j < 4; ++j) { const int n = (lane >> 3) + 8 * j; const LAS float* sp = scr + (8 * c) * 33 + n;
            v4u o; o.x = cvtpk(sp[0 * 33], sp[1 * 33]); o.y = cvtpk(sp[2 * 33], sp[3 * 33]); o.z = cvtpk(sp[4 * 33], sp[5 * 33]); o.w = cvtpk(sp[6 * 33], sp[7 * 33]);
            *(GAS v4u*)((bf16*)d.dst + (size_t)n * d.K + 8 * c) = o; }
    }
    LDS_WAIT(); asm volatile("" ::: "memory");
}
constexpr int CV_NB_I = 12320 / 32, CV_I_I = (DM / 64) * CV_NB_I;
constexpr int CV_NB_O = DM / 32, CV_NB_U = NUP / 32, CV_NB_D = DM / 32, CV_I_O = (DM / 64) * CV_NB_O, CV_I_U = (DM / 64) * CV_NB_U, CV_I_D = (DFF / 64) * CV_NB_D, CV_I_REST = CV_I_O + CV_I_U + CV_I_D;
__device__ __forceinline__ int in_src_col(int n0) {
    if (n0 < 4096) return n0 + 2048; if (n0 < 6144) return n0 - 4096; if (n0 < 8192) return n0 + 32; if (n0 >= 12288) return 6144;
    const int o = n0 - 8192; return ((o & 128) ? 10272 : 8224) + 128 * (o >> 8) + (o & 127);
}
__device__ __forceinline__ CvDesc cv_desc_in(int it, const float* w_in, const float* dummy, const float* CMI, bf16* WI) {
    const int kb = it / CV_NB_I, nb = it - kb * CV_NB_I, n0 = 32 * nb;
    CvDesc d; d.src = w_in + (size_t)(64 * kb) * 12320 + in_src_col(n0); d.ks = dummy; d.N = 12320;
    if (n0 >= 12288) { d.cs = CMI + NI8C; d.dst = (unsigned char*)WI + (size_t)NI8C * DM + 64 * kb; d.K = DM; d.kind = 2; }
    else if (n0 < NI8C) { d.cs = CMI + n0; d.dst = (unsigned char*)WI + (size_t)n0 * DM + 64 * kb; d.K = DM; d.kind = 2; }
    else { d.cs = dummy; d.dst = WI + (size_t)n0 * DM + 64 * kb; d.K = DM; d.kind = 0; }
    return d;
}
__device__ __forceinline__ CvDesc cv_desc_rest(int it, const float* w_out, const float* w_up, const float* w_down, const float* ffn_g, const float* CS, bf16* WO, unsigned char* WU, bf16* WD) {
    CvDesc d; int r = it;
    if (r < CV_I_O) { const int kb = r / CV_NB_O, nb = r - kb * CV_NB_O; d.src = w_out + (size_t)(64 * kb) * DM + 32 * nb; d.ks = ffn_g; d.cs = ffn_g; d.dst = WO + (size_t)(32 * nb) * DM + 64 * kb; d.N = DM; d.K = DM; d.kind = 0; return d; }
    r -= CV_I_O;
    if (r < CV_I_U) { const int kb = r / CV_NB_U, nb = r - kb * CV_NB_U, pn = nb >> 3, j = nb & 7;
        const int srcn = j < 4 ? 128 * pn + 32 * j : DFF + 128 * pn + 32 * (j - 4);
        d.src = w_up + (size_t)(64 * kb) * NUP + srcn; d.ks = ffn_g + 64 * kb; d.cs = CS + srcn; d.dst = WU + (size_t)(32 * nb) * DM + 64 * kb; d.N = NUP; d.K = DM; d.kind = 1; return d; }
    r -= CV_I_U;
    { const int kb = r / CV_NB_D, nb = r - kb * CV_NB_D; d.src = w_down + (size_t)(64 * kb) * DM + 32 * nb; d.ks = ffn_g; d.cs = ffn_g; d.dst = WD + (size_t)(32 * nb) * DFF + 64 * kb; d.N = DM; d.K = DFF; d.kind = 0; return d; }
}
__device__ __forceinline__ void norm_row_q(const float* xrow, const float* g, bf16* orow, unsigned char* qrow, float* rf, int lane) {
    f32x4 v[16]; float s = 0.f;
#pragma unroll
    for (int j = 0; j < 8; ++j) { const GAS f32x4* p = (const GAS f32x4*)(xrow + 8 * lane + 512 * j); v[2 * j] = p[0]; v[2 * j + 1] = p[1]; }
#pragma unroll
    for (int j = 0; j < 16; ++j) s += (v[j].x * v[j].x + v[j].y * v[j].y) + (v[j].z * v[j].z + v[j].w * v[j].w);
    const float rstd = 1.0f / sqrtf(wave_sum(s) * (1.0f / 4096.0f) + EPS);
    float amax = 0.f;
#pragma unroll
    for (int j = 0; j < 8; ++j) { const GAS f32x4* gp = (const GAS f32x4*)(g + 8 * lane + 512 * j); const f32x4 a = v[2 * j] * rstd * gp[0], b = v[2 * j + 1] * rstd * gp[1]; v[2 * j] = a; v[2 * j + 1] = b;
        amax = fmaxf(amax, fmaxf(fmaxf(fmaxf(fabsf(a.x), fabsf(a.y)), fmaxf(fabsf(a.z), fabsf(a.w))), fmaxf(fmaxf(fabsf(b.x), fabsf(b.y)), fmaxf(fabsf(b.z), fabsf(b.w)))));
        v4u o; o.x = cvtpk(a.x, a.y); o.y = cvtpk(a.z, a.w); o.z = cvtpk(b.x, b.y); o.w = cvtpk(b.z, b.w); *(GAS v4u*)(orow + 8 * lane + 512 * j) = o; }
    amax = wave_max(amax); const float sc = amax > 0.f ? 127.0f / amax : 0.f;
#pragma unroll
    for (int j = 0; j < 8; ++j) { const f32x4 a = v[2 * j] * sc, b = v[2 * j + 1] * sc; u32x2v o; o.x = q8x4(a.x, a.y, a.z, a.w); o.y = q8x4(b.x, b.y, b.z, b.w); *(GAS u32x2v*)(qrow + 8 * lane + 512 * j) = o; }
    if (lane == 0) *rf = amax * (1.0f / 127.0f);
}

__device__ __forceinline__ float fexp(float x) { return __builtin_amdgcn_exp2f(x * 1.4426950408889634f); }
__device__ __forceinline__ float logsig16(float x) { return (fminf(x, 0.f) - __builtin_amdgcn_logf(1.0f + fexp(-fabsf(x))) * 0.6931471805599453f) * 0.0625f; }
template <int PVAR> __device__ __forceinline__ void prep_item(int it, LAS unsigned char* lds, const float* AD, const bf16* PQK, const bf16* PV, const float* wg2, const float* bg2, bf16* QT, bf16* KT, bf16* KH, float* ED, bf16* VT, int tid, int wave, int lane) {
    const int cs = it >> 3, h = it & 7; int s, c; cs_decode(cs, s, c);
    asm volatile("" : "+v"(tid)); lane = tid & 63;
    LAS float* sA = (LAS float*)lds;
    LAS float* sT = (LAS float*)(lds + 8192);
    const int dp = lane, tg = wave, fr = lane & 15, fq = lane >> 4, tb = wave >> 1;
    const int rowa = chunk_row(s, c, tid >> 3), rowv = chunk_row(s, c, 16 * tb + fr);
    f32x4 a4 = *(const GAS f32x4*)(AD + (size_t)(rowa >= 0 ? rowa : 0) * 32 + (tid & 7) * 4);
    unsigned qw[8], kw[8];
#pragma unroll
    for (int j = 0; j < 8; ++j) { const int row = chunk_row(s, c, 8 * tg + j); const size_t ro = (size_t)(row >= 0 ? row : 0) * 2048 + h * 128 + 2 * dp;
        qw[j] = *(const GAS unsigned*)(PQK + ro); kw[j] = *(const GAS unsigned*)(PQK + ro + 1024); if (row < 0) { qw[j] = 0u; kw[j] = 0u; } }
    v4u va[4];
#pragma unroll
    for (int kbi = 0; kbi < 4; ++kbi) { va[kbi] = *(const GAS v4u*)(PV + (size_t)(rowv >= 0 ? rowv : 0) * 2048 + h * 256 + 32 * ((wave & 1) * 4 + kbi) + 8 * fq); if (rowv < 0) va[kbi] = (v4u){0u, 0u, 0u, 0u}; }
    if (rowa < 0) a4 = (f32x4){0.f, 0.f, 0.f, 0.f};
    *(LAS f32x4*)(sA + (tid >> 3) * 32 + (tid & 7) * 4) = a4;
    __syncthreads();
    f32x2v lf[8], lb[8];
#pragma unroll
    for (int zz = 0; zz < 2; ++zz) {
        f32x2v w[16];
#pragma unroll
        for (int i = 0; i < 16; ++i) w[i] = *(const GAS f32x2v*)(wg2 + zz * 16384 + (size_t)i * 1024 + h * 128 + 2 * dp);
        const f32x2v bw = *(const GAS f32x2v*)(bg2 + zz * 1024 + h * 128 + 2 * dp);
#pragma unroll
        for (int j = 0; j < 8; ++j) { const int i = 8 * tg + j; const bool padtok = (c == 0 && i < 48);
            f32x2v x = bw;
#pragma unroll
            for (int k4 = 0; k4 < 4; ++k4) { const f32x4 a = *(const LAS f32x4*)(sA + i * 32 + 16 * zz + 4 * k4);
                x += w[4 * k4] * a.x + w[4 * k4 + 1] * a.y + w[4 * k4 + 2] * a.z + w[4 * k4 + 3] * a.w; }
            const f32x2v l = (f32x2v){padtok ? 0.f : logsig16(x.x), padtok ? 0.f : logsig16(x.y)};
            if (zz == 0) lf[j] = l; else lb[j] = l; }
    }
#pragma unroll
    for (int j = 1; j < 8; ++j) lf[j] += lf[j - 1];
#pragma unroll
    for (int j = 6; j >= 0; --j) lb[j] += lb[j + 1];
    *(LAS f32x2v*)(sT + tg * 128 + 2 * dp) = lf[7];
    *(LAS f32x2v*)(sT + 1024 + tg * 128 + 2 * dp) = lb[0];
    __syncthreads();
    f32x2v offf = (f32x2v){0.f, 0.f}, offb = offf, allf = offf, allb = offf;
#pragma unroll
    for (int g = 0; g < 8; ++g) { const f32x2v tf = *(const LAS f32x2v*)(sT + g * 128 + 2 * dp), tb2 = *(const LAS f32x2v*)(sT + 1024 + g * 128 + 2 * dp);
        allf += tf; allb += tb2; if (g < tg) offf += tf; if (g > tg) offb += tb2; }
    const size_t ib = (size_t)it * 8192, zb = (size_t)NITEM * 8192;
    bf16 *QTf = QT + ib, *QTb = QT + zb + ib, *KTf = KT + ib, *KTb = KT + zb + ib, *KHf = KH + ib, *KHb = KH + zb + ib;
    const float qs = 0.08838834764831845f;
    const f32x2v eaf = (f32x2v){fexp(allf.x), fexp(allf.y)}, eab = (f32x2v){fexp(allb.x), fexp(allb.y)};
    unsigned khf0[4], khf1[4], khb0[4], khb1[4];
    float pf0 = 0.f, pf1 = 0.f, pb0 = 0.f, pb1 = 0.f;
#pragma unroll
    for (int j = 0; j < 8; ++j) { const int i = 8 * tg + j;
        const float q0 = bflo(qw[j]) * qs, q1 = bfhi(qw[j]) * qs, k0 = bflo(kw[j]), k1 = bfhi(kw[j]);
        const f32x2v Bp = offf + lf[j], Bs = offb + lb[j];
        const float ef0 = fexp(Bp.x), ef1 = fexp(Bp.y), eb0 = fexp(Bs.x), eb1 = fexp(Bs.y);
        const float rf0 = __builtin_amdgcn_rcpf(ef0), rf1 = __builtin_amdgcn_rcpf(ef1), rb0 = __builtin_amdgcn_rcpf(eb0), rb1 = __builtin_amdgcn_rcpf(eb1);
        if (PVAR != 1) { *(GAS unsigned*)(QTf + i * 128 + 2 * dp) = cvtpk(q0 * ef0, q1 * ef1);
        *(GAS unsigned*)(QTb + i * 128 + 2 * dp) = cvtpk(q0 * eb0, q1 * eb1); } else { asm volatile("" :: "v"(q0 * ef0), "v"(q1 * ef1), "v"(q0 * eb0), "v"(q1 * eb1)); }
        const float ktf0 = k0 * rf0, ktf1 = k1 * rf1, ktb0 = k0 * rb0, ktb1 = k1 * rb1;
        if (PVAR != 1) { *(GAS unsigned*)(KTf + i * 128 + 2 * dp) = cvtpk(ktf0, ktf1);
        *(GAS unsigned*)(KTb + i * 128 + 2 * dp) = cvtpk(ktb0, ktb1); }
        const float hf0 = ktf0 * eaf.x, hf1 = ktf1 * eaf.y, hb0 = ktb0 * eab.x, hb1 = ktb1 * eab.y;
        if (j & 1) { khf0[j >> 1] = cvtpk(pf0, hf0); khf1[j >> 1] = cvtpk(pf1, hf1); khb0[j >> 1] = cvtpk(pb0, hb0); khb1[j >> 1] = cvtpk(pb1, hb1); }
        else { pf0 = hf0; pf1 = hf1; pb0 = hb0; pb1 = hb1; } }
    LAS unsigned char* sKf = lds + 16384; LAS unsigned char* sKb = lds + 34816; LAS unsigned char* sV = lds + 53248;
    *(LAS v4u*)(sKf + (2 * dp) * 144 + 16 * tg) = (v4u){khf0[0], khf0[1], khf0[2], khf0[3]};
    *(LAS v4u*)(sKf + (2 * dp + 1) * 144 + 16 * tg) = (v4u){khf1[0], khf1[1], khf1[2], khf1[3]};
    *(LAS v4u*)(sKb + (2 * dp) * 144 + 16 * tg) = (v4u){khb0[0], khb0[1], khb0[2], khb0[3]};
    *(LAS v4u*)(sKb + (2 * dp + 1) * 144 + 16 * tg) = (v4u){khb1[0], khb1[1], khb1[2], khb1[3]};
    if (tg == 0) { *(GAS f32x2v*)(ED + (size_t)it * 128 + 2 * dp) = eaf;
                   *(GAS f32x2v*)(ED + (size_t)(NITEM + it) * 128 + 2 * dp) = eab; }
    { short e0[8], e1[8];
#pragma unroll
      for (int j = 0; j < 8; ++j) { e0[j] = (8 * fq + j == fr) ? (short)0x3F80 : (short)0; e1[j] = (8 * fq + j == fr + 16) ? (short)0x3F80 : (short)0; }
      const bf16x8 sel0 = (bf16x8){e0[0], e0[1], e0[2], e0[3], e0[4], e0[5], e0[6], e0[7]}, sel1 = (bf16x8){e1[0], e1[1], e1[2], e1[3], e1[4], e1[5], e1[6], e1[7]};
      bf16* vt = VT + (size_t)it * 16384;
#pragma unroll
      for (int kbi = 0; kbi < 4; ++kbi) { const int kb = (wave & 1) * 4 + kbi;
          const bf16x8 A = __builtin_bit_cast(bf16x8, va[kbi]);
          const f32x4 d0 = __builtin_amdgcn_mfma_f32_16x16x32_bf16(A, sel0, (f32x4){0.f, 0.f, 0.f, 0.f}, 0, 0, 0), d1 = __builtin_amdgcn_mfma_f32_16x16x32_bf16(A, sel1, (f32x4){0.f, 0.f, 0.f, 0.f}, 0, 0, 0);
          *(LAS u32x2v*)(sV + (32 * kb + fr) * 144 + (16 * tb + 4 * fq) * 2) = (u32x2v){cvtpk(d0[0], d0[1]), cvtpk(d0[2], d0[3])};
          *(LAS u32x2v*)(sV + (32 * kb + 16 + fr) * 144 + (16 * tb + 4 * fq) * 2) = (u32x2v){cvtpk(d1[0], d1[1]), cvtpk(d1[2], d1[3])}; }
      __syncthreads();
#pragma unroll
      for (int i = 0; i < 2; ++i) { const int q = tid + 512 * i, o = (q >> 3) * 144 + (q & 7) * 16;
          ((GAS v4u*)KHf)[q] = *(const LAS v4u*)(sKf + o); ((GAS v4u*)KHb)[q] = *(const LAS v4u*)(sKb + o); }
#pragma unroll
      for (int i = 0; i < 4; ++i) { const int q = tid + 512 * i; ((GAS v4u*)vt)[q] = *(const LAS v4u*)(sV + (q >> 3) * 144 + (q & 7) * 16); } }
}
__device__ __forceinline__ void load_m8(const bf16* PC, int row, int ch0, float (&m)[8]) {
    const v4u a = *(const GAS v4u*)(PC + (size_t)row * 4096 + 2048 + ch0);
    m[0] = bflo(a.x); m[1] = bfhi(a.x); m[2] = bflo(a.y); m[3] = bfhi(a.y); m[4] = bflo(a.z); m[5] = bfhi(a.z); m[6] = bflo(a.w); m[7] = bfhi(a.w);
}
constexpr int NCONV = 2 * 257 + 4 * 129;
__device__ __forceinline__ void conv_item(int ci, const bf16* PC, const float* cw, bf16* MIX, int tid) {
    asm volatile("" : "+v"(tid));
    int s, blk; if (ci < 514) { s = ci >= 257 ? 1 : 0; blk = ci - s * 257; } else { const int j = ci - 514; s = 2 + j / 129; blk = j - (s - 2) * 129; }
    const int np = seq_len(s) + 16, ch0 = 8 * (tid & 255), p0 = 16 * blk + 8 * (tid >> 8);
    float m[10][8]; v4u cbw[8];
#pragma unroll
    for (int j = 0; j < 10; ++j) { const int p = p0 - 1 + j;
        if (p >= 0 && p < np) load_m8(PC, pos_row(s, p), ch0, m[j]);
        else {
#pragma unroll
            for (int e = 0; e < 8; ++e) m[j][e] = 0.f; } }
#pragma unroll
    for (int j = 0; j < 8; ++j) cbw[j] = *(const GAS v4u*)(PC + (size_t)pos_row(s, p0 + j) * 4096 + ch0);
    float w0[8], w1[8], w2[8];
#pragma unroll
    for (int e = 0; e < 8; ++e) { w0[e] = cw[ch0 + e]; w1[e] = cw[2048 + ch0 + e]; w2[e] = cw[4096 + ch0 + e]; }
#pragma unroll
    for (int j = 0; j < 8; ++j) { const v4u c4 = cbw[j];
        const float cbv[8] = {bflo(c4.x), bfhi(c4.x), bflo(c4.y), bfhi(c4.y), bflo(c4.z), bfhi(c4.z), bflo(c4.w), bfhi(c4.w)};
        float o[8];
#pragma unroll
        for (int e = 0; e < 8; ++e) o[e] = cbv[e] * (w0[e] * m[j][e] + w1[e] * m[j + 1][e] + w2[e] * m[j + 2][e]);
        v4u ow; ow.x = cvtpk(o[0], o[1]); ow.y = cvtpk(o[2], o[3]); ow.z = cvtpk(o[4], o[5]); ow.w = cvtpk(o[6], o[7]);
        *(GAS v4u*)(MIX + (size_t)pos_row(s, p0 + j) * 4096 + 2048 + ch0) = ow; }
}

#ifndef SCAN_DIST
#define SCAN_DIST 2
#endif
constexpr int SC_BUF = 51712, SC_KT = 16384, SC_KH = 32768, SC_ED = 51200, SC_P = 2 * SC_BUF;
__device__ __forceinline__ bf16x8 mk8(unsigned a, unsigned b, unsigned c, unsigned d) { const v4u t = (v4u){a, b, c, d}; return __builtin_bit_cast(bf16x8, t); }
struct ScanRegs { v4u q[2], k[2], h[2], v[2]; f32x4 ed; };
template <int SVAR> __device__ __forceinline__ void scan_item(int idx, LAS unsigned char* lds, const bf16* QT, const bf16* KT, const bf16* KH, const float* ED, const bf16* VT, bf16* O2, int tid, int wave, int lane) {
    int s, rem; if (idx < 64) { s = idx >> 5; rem = idx & 31; } else { s = 2 + ((idx - 64) >> 5); rem = (idx - 64) & 31; }
    const int h = rem >> 2, z = (rem >> 1) & 1, vh = rem & 1;
    const int nc = seq_nchunks(s), cbase = seq_chunkbase(s);
    const int fr = lane & 15, fq = lane >> 4;
    const int vrow = vh * 128 + 16 * wave + fr;
    const int ocol = h * 256 + vh * 128 + 16 * wave + 4 * fq;
    f32x4 Sacc[8];
#pragma unroll
    for (int i = 0; i < 8; ++i) Sacc[i] = (f32x4){0.f, 0.f, 0.f, 0.f};
    ScanRegs RA, RB; bf16x8 vcur[2];
    RA.ed = (f32x4){0.f, 0.f, 0.f, 0.f}; RB.ed = RA.ed;
#define SC_CH(st_) (z ? nc - 1 - (st_) : (st_))
#define SC_LOAD(R_, c_) do { const int it_ = (cbase + (c_)) * 8 + h; const size_t ib_ = ((size_t)z * NITEM + it_) * 8192; \
        _Pragma("unroll") for (int i_ = 0; i_ < 2; ++i_) { R_.q[i_] = ((const GAS v4u*)(QT + ib_))[tid + 512 * i_]; R_.k[i_] = ((const GAS v4u*)(KT + ib_))[tid + 512 * i_]; R_.h[i_] = ((const GAS v4u*)(KH + ib_))[tid + 512 * i_]; \
            R_.v[i_] = *(const GAS v4u*)(VT + (size_t)it_ * 16384 + (size_t)vrow * 64 + 32 * i_ + 8 * fq); } \
        R_.ed = ((const GAS f32x4*)(ED + ((size_t)z * NITEM + it_) * 128))[tid & 31]; } while (0)
#define SC_WRITE(R_, b_) do { LAS unsigned char* bb_ = lds + (b_) * SC_BUF; \
        _Pragma("unroll") for (int i_ = 0; i_ < 2; ++i_) { const int q_ = tid + 512 * i_; const int r_ = q_ >> 4, c_ = q_ & 15; const int o_ = r_ * 256 + ((c_ ^ (r_ & 15)) << 4); \
            *(LAS v4u*)(bb_ + o_) = R_.q[i_]; *(LAS v4u*)(bb_ + SC_KT + o_) = R_.k[i_]; *(LAS v4u*)(bb_ + SC_KH + (q_ >> 3) * 144 + (q_ & 7) * 16) = R_.h[i_]; } \
        if (tid < 32) *(LAS f32x4*)(bb_ + SC_ED + tid * 16) = R_.ed; \
        vcur[0] = __builtin_bit_cast(bf16x8, R_.v[0]); vcur[1] = __builtin_bit_cast(bf16x8, R_.v[1]); } while (0)
#define SC_STEP(step_, b_, RL_, RW_, DIST_, LAST_) do { const int c = SC_CH(step_); \
        LAS unsigned char* QTb = lds + (b_) * SC_BUF; LAS unsigned char* KTb = QTb + SC_KT; LAS unsigned char* KHb = QTb + SC_KH; LAS unsigned char* EDb = QTb + SC_ED; LAS unsigned char* Pb = lds + SC_P; \
        if (!(LAST_) && SVAR != 1) { const int sl_ = (step_) + (DIST_) < nc ? (step_) + (DIST_) : nc - 1; SC_LOAD(RL_, SC_CH(sl_)); }     \
          \
        _Pragma("unroll") for (int e2 = 0; e2 < 2; ++e2) { const int e = 2 * wave + e2, si = e >> 2, ti = e & 3; \
            f32x4 a4 = (f32x4){0.f, 0.f, 0.f, 0.f}; \
            _Pragma("unroll") for (int kk = 0; kk < 4; ++kk) { const int off = (((4 * kk + fq) ^ fr) << 4); \
                const bf16x8 A = *(const LAS bf16x8*)(KTb + (16 * si + fr) * 256 + off), B = *(const LAS bf16x8*)(QTb + (16 * ti + fr) * 256 + off); \
                a4 = __builtin_amdgcn_mfma_f32_16x16x32_bf16(A, B, a4, 0, 0, 0); } \
            const int tg_ = 16 * ti + fr, sg0 = 16 * si + 4 * fq; float p[4]; \
            _Pragma("unroll") for (int r = 0; r < 4; ++r) { const int sg = sg0 + r; const bool keep = z ? (sg > tg_) : (sg <= tg_); p[r] = keep ? a4[r] : 0.f; } \
            *(LAS u32x2v*)(Pb + tg_ * 144 + sg0 * 2) = (u32x2v){cvtpk(p[0], p[1]), cvtpk(p[2], p[3])}; } \
          \
        f32x4 oacc[4]; \
        _Pragma("unroll") for (int ti = 0; ti < 4; ++ti) oacc[ti] = (f32x4){0.f, 0.f, 0.f, 0.f}; \
        _Pragma("unroll") for (int kk = 0; kk < 4; ++kk) { \
            const bf16x8 Sb = mk8(cvtpk(Sacc[2 * kk][0], Sacc[2 * kk][1]), cvtpk(Sacc[2 * kk][2], Sacc[2 * kk][3]), cvtpk(Sacc[2 * kk + 1][0], Sacc[2 * kk + 1][1]), cvtpk(Sacc[2 * kk + 1][2], Sacc[2 * kk + 1][3])); \
            _Pragma("unroll") for (int ti = 0; ti < 4; ++ti) { const LAS unsigned char* rp = QTb + (16 * ti + fr) * 256 + (fq & 1) * 8; \
                const u32x2v lo = *(const LAS u32x2v*)(rp + (((4 * kk + (fq >> 1)) ^ fr) << 4)), hi = *(const LAS u32x2v*)(rp + (((4 * kk + 2 + (fq >> 1)) ^ fr) << 4)); \
                oacc[ti] = __builtin_amdgcn_mfma_f32_16x16x32_bf16(Sb, mk8(lo.x, lo.y, hi.x, hi.y), oacc[ti], 0, 0, 0); } } \
        __syncthreads();                                \
          \
        _Pragma("unroll") for (int ti = 0; ti < 4; ++ti) \
            _Pragma("unroll") for (int kk = 0; kk < 2; ++kk) { const bf16x8 Bp = *(const LAS bf16x8*)(Pb + (16 * ti + fr) * 144 + (32 * kk + 8 * fq) * 2); \
                oacc[ti] = __builtin_amdgcn_mfma_f32_16x16x32_bf16(vcur[kk], Bp, oacc[ti], 0, 0, 0); } \
          \
        _Pragma("unroll") for (int ti = 0; ti < 4; ++ti) { int row = chunk_row(s, c, 16 * ti + fr); row = row >= 0 ? row : MP - 1;     \
            if (SVAR == 0) *(GAS u32x2v*)(O2 + ((size_t)z * MP + row) * 2048 + ocol) = (u32x2v){cvtpk(oacc[ti][0], oacc[ti][1]), cvtpk(oacc[ti][2], oacc[ti][3])}; else asm volatile("" :: "v"(oacc[ti])); } \
          \
        _Pragma("unroll") for (int i8 = 0; i8 < 8; ++i8) { const f32x4 ed4 = *(const LAS f32x4*)(EDb + (16 * i8 + 4 * fq) * 4); Sacc[i8] = Sacc[i8] * ed4; \
            _Pragma("unroll") for (int kk = 0; kk < 2; ++kk) { const bf16x8 A = *(const LAS bf16x8*)(KHb + (16 * i8 + fr) * 144 + (32 * kk + 8 * fq) * 2); \
                Sacc[i8] = __builtin_amdgcn_mfma_f32_16x16x32_bf16(A, vcur[kk], Sacc[i8], 0, 0, 0); } } \
        if (!(LAST_) && SVAR != 1) SC_WRITE(RW_, (b_) ^ 1); \
        __syncthreads(); } while (0)
    SC_LOAD(RA, SC_CH(0)); SC_WRITE(RA, 0);
#if SCAN_DIST == 2
    SC_LOAD(RB, SC_CH(1));
    __syncthreads();
    for (int step = 0; step + 1 < nc; step += 2) {
        SC_STEP(step, 0, RA, RB, 2, false);
        SC_STEP(step + 1, 1, RB, RA, 2, false);
    }
    SC_STEP(nc - 1, 0, RA, RB, 2, true);
#else
    __syncthreads();
    for (int step = 0; step + 1 < nc; step += 2) {
        SC_STEP(step, 0, RA, RA, 1, false);
        SC_STEP(step + 1, 1, RA, RA, 1, false);
    }
    SC_STEP(nc - 1, 0, RA, RA, 1, true);
#endif
#undef SC_CH
#undef SC_LOAD
#undef SC_WRITE
#undef SC_STEP
}

__device__ __forceinline__ void fixup_item(int q, const float* EP, const float* EG, const float* EU, const float* EGM, const float* fw, bf16* H) {
    const int er = q / 1376, cg = q - er * 1376, pm = er >> 1, e = er & 1, f0 = 8 * cg;
    const int s = pm < 32 ? (pm >> 4) : 2 + ((pm - 32) >> 3);
    const bool first = pm < 32 ? ((pm & 15) == 0) : (((pm - 32) & 7) == 0), last = pm < 32 ? ((pm & 15) == 15) : (((pm - 32) & 7) == 7);
    const size_t eo = ((size_t)pm * 2 + e) * DFF + f0;
    f32x4 nb0 = (f32x4){0.f, 0.f, 0.f, 0.f}, nb1 = nb0, wv0, wv1;
    if (e == 0) { const float* gsrc = first ? EGM + (size_t)s * DFF + f0 : EG + ((size_t)(pm - 1) * 2 + 1) * DFF + f0; nb0 = *(const GAS f32x4*)gsrc; nb1 = *(const GAS f32x4*)(gsrc + 4);
                  wv0 = *(const GAS f32x4*)(fw + f0); wv1 = *(const GAS f32x4*)(fw + f0 + 4); }
    else { if (!last) { const float* gsrc = EG + ((size_t)(pm + 1) * 2) * DFF + f0; nb0 = *(const GAS f32x4*)gsrc; nb1 = *(const GAS f32x4*)(gsrc + 4); }
           wv0 = *(const GAS f32x4*)(fw + 2 * DFF + f0); wv1 = *(const GAS f32x4*)(fw + 2 * DFF + f0 + 4); }
    const f32x4 p0 = *(const GAS f32x4*)(EP + eo) + wv0 * nb0, p1 = *(const GAS f32x4*)(EP + eo + 4) + wv1 * nb1;
    const f32x4 u0 = *(const GAS f32x4*)(EU + eo), u1 = *(const GAS f32x4*)(EU + eo + 4);
    float o[8];
#pragma unroll
    for (int j = 0; j < 4; ++j) { o[j] = p0[j] * __builtin_amdgcn_rcpf(1.0f + __builtin_amdgcn_exp2f(-1.4426950408889634f * p0[j])) * u0[j];
                                  o[4 + j] = p1[j] * __builtin_amdgcn_rcpf(1.0f + __builtin_amdgcn_exp2f(-1.4426950408889634f * p1[j])) * u1[j]; }
    v4u ow; ow.x = cvtpk(o[0], o[1]); ow.y = cvtpk(o[2], o[3]); ow.z = cvtpk(o[4], o[5]); ow.w = cvtpk(o[6], o[7]);
    *(GAS v4u*)(H + (size_t)(pm * 256 + (e ? 255 : 0)) * DFF + f0) = ow;
}

__device__ __forceinline__ f32x4 thin_tile(const bf16* arow, const bf16* brow, int fq) {
    f32x4 acc = (f32x4){0.f, 0.f, 0.f, 0.f};
    for (int kb = 0; kb < 8; ++kb) {
        v4u a[16], bb[16];
#pragma unroll
        for (int i = 0; i < 16; ++i) { a[i] = *(const GAS v4u*)(arow + kb * 512 + 32 * i + 8 * fq); bb[i] = *(const GAS v4u*)(brow + kb * 512 + 32 * i + 8 * fq); }
#pragma unroll
        for (int i = 0; i < 16; ++i) acc = __builtin_amdgcn_mfma_f32_16x16x32_bf16(__builtin_bit_cast(bf16x8, a[i]), __builtin_bit_cast(bf16x8, bb[i]), acc, 0, 0, 0);
    }
    return acc;
}

__device__ __forceinline__ pg8::i32x4 thin_tile_i8(const unsigned char* arow, const unsigned char* brow, int fq) {
    pg8::i32x4 acc = (pg8::i32x4){0, 0, 0, 0};
    for (int kb = 0; kb < 4; ++kb) {
        v4u a[16], bb[16];
#pragma unroll
        for (int i = 0; i < 16; ++i) { a[i] = *(const GAS v4u*)(arow + kb * 1024 + 64 * i + 16 * fq); bb[i] = *(const GAS v4u*)(brow + kb * 1024 + 64 * i + 16 * fq); }
#pragma unroll
        for (int i = 0; i < 16; ++i) acc = __builtin_amdgcn_mfma_i32_16x16x64_i8(__builtin_bit_cast(pg8::i32x4, a[i]), __builtin_bit_cast(pg8::i32x4, bb[i]), acc, 0, 0, 0);
    }
    return acc;
}

struct Args { const float* in[16]; float* out; unsigned char* ws; int ph_lo, ph_hi; };
__global__ void __launch_bounds__(NWAVES * 64, 2) fwd(Args args) {
    extern __shared__ __attribute__((aligned(16))) unsigned char lds_raw[];
    LAS unsigned char* lds = (LAS unsigned char*)lds_raw;
    volatile LAS unsigned* MISC = (volatile LAS unsigned*)(lds + MISC_OFF);
    const int tid = threadIdx.x, lane = tid & 63, wave = __builtin_amdgcn_readfirstlane(tid >> 6);
    const int G = gridDim.x, bid = blockIdx.x;
    const int gw = bid * NWAVES + wave, NGW = G * NWAVES;
    unsigned char* ws = args.ws;
    gu32* ctl = (gu32*)(ws + WS_CTL);
    const float *x_prompt = args.in[0], *x_sample = args.in[1], *meta = args.in[2], *mix_g = args.in[3], *w_in = args.in[4], *wg2 = args.in[5], *bg2 = args.in[6], *hng = args.in[7],
                *cmw = args.in[8], *w_out = args.in[9], *ffn_g = args.in[10], *w_up = args.in[11], *fcw = args.in[12], *fcb = args.in[13], *w_down = args.in[14], *fin_g = args.in[15];
    float* out = args.out;
    float* AD = (float*)(ws + WS_AD); float* X1M = (float*)(ws + WS_X1M);
    bf16 *WD = (bf16*)(ws + WS_WD), *WI = (bf16*)(ws + WS_WI), *WO = (bf16*)(ws + WS_WO), *XN = (bf16*)(ws + WS_XN);
    unsigned char *WU = ws + WS_WU, *XQ = ws + WS_XQ, *WI8 = ws + WS_WI; float *CMAXP = (float*)(ws + WS_CMAXP), *CS = (float*)(ws + WS_CS), *RFI = (float*)(ws + WS_RFI); float* CMI = (float*)(ctl + CW_CMI);
    bf16 *PQK = (bf16*)(ws + WS_PQK), *PC = (bf16*)(ws + WS_PC), *PV = (bf16*)(ws + WS_PV), *PR = (bf16*)(ws + WS_PR);
    bf16 *QT = (bf16*)(ws + WS_QT), *KT = (bf16*)(ws + WS_KT), *KH = (bf16*)(ws + WS_KH), *VT = (bf16*)(ws + WS_VT); float* ED = (float*)(ws + WS_ED);
    bf16 *MIX = (bf16*)(ws + WS_MIX), *O2 = (bf16*)(ws + WS_O2), *HB = (bf16*)(ws + WS_H);
    float* PART = (float*)(ws + WS_PART);
    float *EP = (float*)(ws + WS_EP), *EG = (float*)(ws + WS_EG), *EU = (float*)(ws + WS_EU), *EGM = (float*)(ws + WS_EGM), *SSQ = (float*)(ws + WS_SSQ), *RSTD = (float*)(ws + WS_RSTD);

    for (int u = tid; u < (LDS_BYTES - RING_BYTES) / 4; u += NWAVES * 64) ((LAS unsigned*)(lds + RING_BYTES))[u] = 0u;
    __syncthreads();
    const int lo = args.ph_lo, hi = args.ph_hi;
    const bool use_bar = (hi - lo) > 1;
    XcdBarrier bar; bar.bar = (unsigned*)(ctl + CW_BAR); bar.x = 0; bar.st = nullptr;
    if (use_bar) bar = xcd_barrier_post((unsigned*)(ctl + CW_BAR), MISC + 8);
#ifndef PROBE_PHASE
#define PROBE_PHASE -1
#endif
#define REP(k) for (int rep_ = 0; rep_ < ((PROBE_PHASE == (k)) ? 2 : 1); ++rep_)
#define IN(k) (lo <= (k) && (k) < hi)
#define SEAM(k) do { if (IN(k) && IN((k) + 1)) xcd_barrier(bar); } while (0)

    if (IN(0)) REP(0) {
        for (int it = gw; it < 64 * 86; it += NGW) { const int kb = it / 86, cb = it - kb * 86;
            const float* src = w_up + (size_t)(64 * kb) * NUP + 256 * cb + 4 * lane; f32x4 mx = (f32x4){0.f, 0.f, 0.f, 0.f};
#pragma unroll 1
            for (int b = 0; b < 4; ++b) { f32x4 t[16];
#pragma unroll
                for (int i = 0; i < 16; ++i) t[i] = __builtin_nontemporal_load((const GAS f32x4*)(src + (size_t)(16 * b + i) * NUP));
#pragma unroll
                for (int i = 0; i < 16; ++i) { const float gk = fabsf(ffn_g[64 * kb + 16 * b + i]);
                    mx.x = fmaxf(mx.x, fabsf(t[i].x) * gk); mx.y = fmaxf(mx.y, fabsf(t[i].y) * gk); mx.z = fmaxf(mx.z, fabsf(t[i].z) * gk); mx.w = fmaxf(mx.w, fabsf(t[i].w) * gk); } }
            *(GAS f32x4*)(CMAXP + (size_t)kb * NUP + 256 * cb + 4 * lane) = mx; }
        for (int it = gw; it < 64 * NI8T; it += NGW) { const int kb = it / NI8T, cb = it - kb * NI8T;
            const float* src = w_in + (size_t)(64 * kb) * 12320 + in_src_col(256 * cb) + 4 * lane; float m0 = 0.f, m1 = 0.f, m2 = 0.f, m3 = 0.f;
#pragma unroll 1
            for (int b = 0; b < 4; ++b) { f32x4 t[16];
#pragma unroll
                for (int i = 0; i < 16; ++i) t[i] = __builtin_nontemporal_load((const GAS f32x4*)(src + (size_t)(16 * b + i) * 12320));
#pragma unroll
                for (int i = 0; i < 16; ++i) { m0 = fmaxf(m0, fabsf(t[i].x)); m1 = fmaxf(m1, fabsf(t[i].y)); m2 = fmaxf(m2, fabsf(t[i].z)); m3 = fmaxf(m3, fabsf(t[i].w)); } }
            unsigned* cm = (unsigned*)CMI + 256 * cb + 4 * lane;
            __hip_atomic_fetch_max(cm + 0, __builtin_bit_cast(unsigned, m0), __ATOMIC_RELAXED, __HIP_MEMORY_SCOPE_AGENT); __hip_atomic_fetch_max(cm + 1, __builtin_bit_cast(unsigned, m1), __ATOMIC_RELAXED, __HIP_MEMORY_SCOPE_AGENT);
            __hip_atomic_fetch_max(cm + 2, __builtin_bit_cast(unsigned, m2), __ATOMIC_RELAXED, __HIP_MEMORY_SCOPE_AGENT); __hip_atomic_fetch_max(cm + 3, __builtin_bit_cast(unsigned, m3), __ATOMIC_RELAXED, __HIP_MEMORY_SCOPE_AGENT); }
        for (int kb = gw; kb < 64; kb += NGW) { const float* src = w_in + (size_t)(64 * kb) * 12320 + 6144 + 4 * (lane & 7); float m0 = 0.f, m1 = 0.f, m2 = 0.f, m3 = 0.f;
#pragma unroll 1
            for (int b = 0; b < 4; ++b) { f32x4 t[16];
#pragma unroll
                for (int i = 0; i < 16; ++i) t[i] = *(const GAS f32x4*)(src + (size_t)(16 * b + i) * 12320);
#pragma unroll
                for (int i = 0; i < 16; ++i) { m0 = fmaxf(m0, fabsf(t[i].x)); m1 = fmaxf(m1, fabsf(t[i].y)); m2 = fmaxf(m2, fabsf(t[i].z)); m3 = fmaxf(m3, fabsf(t[i].w)); } }
            if (lane < 8) { unsigned* cm = (unsigned*)CMI + NI8C + 4 * lane;
                __hip_atomic_fetch_max(cm + 0, __builtin_bit_cast(unsigned, m0), __ATOMIC_RELAXED, __HIP_MEMORY_SCOPE_AGENT); __hip_atomic_fetch_max(cm + 1, __builtin_bit_cast(unsigned, m1), __ATOMIC_RELAXED, __HIP_MEMORY_SCOPE_AGENT);
                __hip_atomic_fetch_max(cm + 2, __builtin_bit_cast(unsigned, m2), __ATOMIC_RELAXED, __HIP_MEMORY_SCOPE_AGENT); __hip_atomic_fetch_max(cm + 3, __builtin_bit_cast(unsigned, m3), __ATOMIC_RELAXED, __HIP_MEMORY_SCOPE_AGENT); } }
        for (int m = gw; m < MP; m += NGW) {
            if (m < MTOK) { const float* xr = m < 8192 ? x_prompt + (size_t)m * DM : (m < 16384 ? x_sample + (size_t)(m - 8192) * DM : meta + (size_t)((m - 16384) & 15) * DM);
                norm_row_q(xr, mix_g, XN + (size_t)m * DM, XQ + (size_t)m * DM, RFI + m, lane); }
            else { GAS v4u* o = (GAS v4u*)(XN + (size_t)m * DM) + lane; GAS u32x2v* oq = (GAS u32x2v*)(XQ + (size_t)m * DM) + lane;
#pragma unroll
                for (int j = 0; j < 8; ++j) { o[64 * j] = (v4u){0u, 0u, 0u, 0u}; oq[64 * j] = (u32x2v){0u, 0u}; }
                if (lane == 0) RFI[m] = 0.f; }
        }
    }
    SEAM(0);
    if (IN(1)) REP(1) {
        LAS float* scr = (LAS float*)(lds + wave * 16384);
        { CvRegs va, vb; int it = gw;
          if (it < CV_I_I) { CvDesc da = cv_desc_in(it, w_in, ffn_g, CMI, WI); cv_load(da, va, lane);
              for (;;) { const int itb = it + NGW; CvDesc db = da; if (itb < CV_I_I) { db = cv_desc_in(itb, w_in, ffn_g, CMI, WI); cv_load(db, vb, lane); }
                  cv_finish(da, va, scr, lane); if (itb >= CV_I_I) break;
                  it = itb + NGW; if (it < CV_I_I) { da = cv_desc_in(it, w_in, ffn_g, CMI, WI); cv_load(da, va, lane); }
                  cv_finish(db, vb, scr, lane); if (it >= CV_I_I) break; } } }
    }
    SEAM(1);
    if (IN(2)) REP(2) {
        { pg8::Gemm g{(const bf16*)XQ, (const bf16*)WI8, MREAL, NI8C, DM / 2}; pg8::StaticOrder S; S.init(MREAL, NI8C, G, bid);
          pg8::EpiIn8 E{PQK, PV, PR, RFI, CMI};
          pg8::gemm_phase<pg8::EpiIn8, pg8::StaticOrder, true, true, 0, true>(lds, g, S, E); }
        __syncthreads();
        { pg8::Gemm g{XN, WI + (size_t)NI8C * DM, MREAL, 12288 - NI8C, DM}; pg8::StaticOrder S; S.init(MREAL, 12288 - NI8C, G, bid);
          pg8::EpiIn E{PQK, PV, PR, PC, AD, NI8T};
          pg8::gemm_phase<pg8::EpiIn, pg8::StaticOrder, true, true>(lds, g, S, E); }
        { const int fr = lane & 15, fq = lane >> 4;
          for (int blk = bid; blk < MREAL / 64; blk += G) { const int r0 = 64 * blk + 16 * (wave >> 1), c0 = 16 * (wave & 1);
              const pg8::i32x4 di = thin_tile_i8(XQ + (size_t)(r0 + fr) * DM, WI8 + (size_t)(NI8C + c0 + fr) * DM, fq); const float cf = CMI[NI8C + c0 + fr] * (1.0f / 127.0f);
#pragma unroll
              for (int r = 0; r < 4; ++r) AD[(size_t)(r0 + 4 * fq + r) * 32 + c0 + fr] = (float)di[r] * (RFI[r0 + 4 * fq + r] * cf); }
          for (int t = gw; t < 770; t += NGW) { const int n0 = 16 * t; f32x4 d;
              const bool paired = n0 >= 8192 && n0 < 12288;
              if (paired && ((n0 - 8192) & 128)) continue;
              if (n0 < NI8C || n0 >= 12288) { const int q0 = n0 < NI8C ? n0 : NI8C + (n0 - 12288);
                  const pg8::i32x4 di = thin_tile_i8(XQ + (size_t)(MREAL + fr) * DM, WI8 + (size_t)(q0 + fr) * DM, fq); const float cf = CMI[q0 + fr] * (1.0f / 127.0f);
#pragma unroll
                  for (int r = 0; r < 4; ++r) d[r] = (float)di[r] * (RFI[MREAL + 4 * fq + r] * cf); }
              else d = thin_tile(XN + (size_t)(MREAL + fr) * DM, WI + (size_t)(n0 + fr) * DM, fq);
              if (paired) d = d * thin_tile(XN + (size_t)(MREAL + fr) * DM, WI + (size_t)(n0 + 128 + fr) * DM, fq);
              const int n = n0 + fr;
#pragma unroll
              for (int r = 0; r < 4; ++r) { const int i = 4 * fq + r;
                  if (n0 >= 12288) {
#pragma unroll
                      for (int s6 = 0; s6 < 6; ++s6) AD[(size_t)(MREAL + 16 * s6 + i) * 32 + (n - 12288)] = d[r]; }
                  else { bf16* base; int ldc, col; if (n0 < 2048) { base = PV; ldc = 2048; col = n; } else if (n0 < 4096) { base = PR; ldc = 2048; col = n - 2048; } else if (n0 < 6144) { base = PQK; ldc = 2048; col = n - 4096; } else if (n0 < 8192) { base = PC; ldc = 4096; col = n - 6144; } else { base = PC; ldc = 4096; col = 2048 + 128 * ((n0 - 8192) >> 8) + ((n0 - 8192) & 127) + fr; }
                      const unsigned short hv = (unsigned short)(cvtpk(d[r], 0.f) & 0xffffu);
#pragma unroll
                      for (int s6 = 0; s6 < 6; ++s6) base[(size_t)(MREAL + 16 * s6 + i) * ldc + col] = hv; } } } }
    }
    SEAM(2);
    if (IN(3)) REP(3) {
        for (int n = bid * 512 + tid; n < NUP; n += G * 512) { float m = 0.f;
#pragma unroll 8
            for (int kb = 0; kb < 64; ++kb) m = fmaxf(m, CMAXP[(size_t)kb * NUP + n]);
            CS[n] = m * (1.0f / 127.0f); }
        for (int it = bid; it < NITEM + NCONV; it += G) {
            if (it < NITEM) prep_item<0>(it, lds, AD, PQK, PV, wg2, bg2, QT, KT, KH, ED, VT, tid, wave, lane);
            else conv_item(it - NITEM, PC, cmw, MIX, tid);
        }
#if PROBE_PHASE == 21
        for (int it = NITEM + bid; it < NITEM + NCONV; it += G) conv_item(it - NITEM, PC, cmw, MIX, tid);
#elif PROBE_PHASE >= 22 && PROBE_PHASE <= 29
        for (int it = bid; it < NITEM; it += G) prep_item<PROBE_PHASE - 22>(it, lds, AD, PQK, PV, wg2, bg2, QT, KT, KH, ED, VT, tid, wave, lane);
#endif
    }
    SEAM(3);
    if (IN(4)) REP(4) {
        for (int it = bid; it < 192; it += G) scan_item<0>(it, lds, QT, KT, KH, ED, VT, O2, tid, wave, lane);
        { LAS float* scr = (LAS float*)(lds + wave * 16384); CvRegs va, vb, vc, vd;
          for (;;) { int base = 0; if (lane == 0) base = (int)__hip_atomic_fetch_add(ctl + CW_Q, 16u, __ATOMIC_RELAXED, __HIP_MEMORY_SCOPE_AGENT);
              base = __builtin_amdgcn_readfirstlane(base); if (base >= CV_I_REST) break;
              CvDesc da = cv_desc_rest(base, w_out, w_up, w_down, ffn_g, CS, WO, WU, WD), db = cv_desc_rest(base + 1, w_out, w_up, w_down, ffn_g, CS, WO, WU, WD), dc = cv_desc_rest(base + 2, w_out, w_up, w_down, ffn_g, CS, WO, WU, WD), dd = cv_desc_rest(base + 3, w_out, w_up, w_down, ffn_g, CS, WO, WU, WD);
              cv_load(da, va, lane); cv_load(db, vb, lane); cv_load(dc, vc, lane); cv_load(dd, vd, lane);
              for (int it = base; it < base + 16; it += 4) { const bool more = it + 4 < base + 16;
                  cv_finish(da, va, scr, lane); if (more) { da = cv_desc_rest(it + 4, w_out, w_up, w_down, ffn_g, CS, WO, WU, WD); cv_load(da, va, lane); }
                  cv_finish(db, vb, scr, lane); if (more) { db = cv_desc_rest(it + 5, w_out, w_up, w_down, ffn_g, CS, WO, WU, WD); cv_load(db, vb, lane); }
                  cv_finish(dc, vc, scr, lane); if (more) { dc = cv_desc_rest(it + 6, w_out, w_up, w_down, ffn_g, CS, WO, WU, WD); cv_load(dc, vc, lane); }
                  cv_finish(dd, vd, scr, lane); if (more) { dd = cv_desc_rest(it + 7, w_out, w_up, w_down, ffn_g, CS, WO, WU, WD); cv_load(dd, vd, lane); } } } }
    }
    SEAM(4);
    if (IN(5)) REP(5) {
        const f32x4 g4 = *(const GAS f32x4*)(hng + 4 * lane);
        for (int wi = gw; wi < MTOK * 8; wi += NGW) { const int row = wi >> 3, h = wi & 7;
            const u32x2v a = *(const GAS u32x2v*)(O2 + (size_t)row * 2048 + h * 256 + 4 * lane), b = *(const GAS u32x2v*)(O2 + ((size_t)MP + row) * 2048 + h * 256 + 4 * lane);
            const u32x2v rw = *(const GAS u32x2v*)(PR + (size_t)row * 2048 + h * 256 + 4 * lane);
            const float o0 = bflo(a.x) + bflo(b.x), o1 = bfhi(a.x) + bfhi(b.x), o2 = bflo(a.y) + bflo(b.y), o3 = bfhi(a.y) + bfhi(b.y);
            const float rs = 1.0f / sqrtf(wave_sum((o0 * o0 + o1 * o1) + (o2 * o2 + o3 * o3)) * (1.0f / 256.0f) + EPS);
            const float r0 = bflo(rw.x), r1 = bfhi(rw.x), r2 = bflo(rw.y), r3 = bfhi(rw.y);
            const float y0 = o0 * rs * g4.x * (r0 / (1.0f + expf(-r0))), y1 = o1 * rs * g4.y * (r1 / (1.0f + expf(-r1))), y2 = o2 * rs * g4.z * (r2 / (1.0f + expf(-r2))), y3 = o3 * rs * g4.w * (r3 / (1.0f + expf(-r3)));
            *(GAS u32x2v*)(MIX + (size_t)row * 4096 + h * 256 + 4 * lane) = (u32x2v){cvtpk(y0, y1), cvtpk(y2, y3)}; }
    }
    SEAM(5);
    if (IN(6)) REP(6) {
        pg8::Gemm g{MIX, WO, MREAL, DM, DM}; pg8::StaticOrder S; S.init(MREAL, DM, G, bid);
        pg8::EpiOut E{x_prompt, x_sample, XN, SSQ};
        pg8::gemm_phase<pg8::EpiOut, pg8::StaticOrder, true, true>(lds, g, S, E);
        __syncthreads();
        pg8::Gemm g2{MIX, WO, MP, DM, 256, DM}; pg8::MiniOrder S2{64, 16, 16, G, bid};
        pg8::EpiPart E2{PART};
        pg8::gemm_phase<pg8::EpiPart, pg8::MiniOrder, true, true>(lds, g2, S2, E2);
    }
    SEAM(6);
    if (IN(7)) REP(7) {
        for (int m = gw; m < MREAL; m += NGW) {
            const float sv = SSQ[(size_t)m * 64 + lane]; v4u w[8];
#pragma unroll
            for (int j = 0; j < 8; ++j) w[j] = *(const GAS v4u*)(XN + (size_t)m * DM + 8 * lane + 512 * j);
            const float rstd = 1.0f / sqrtf(wave_sum(sv) * (1.0f / 4096.0f) + EPS);
            float amax = 0.f;
#pragma unroll
            for (int j = 0; j < 8; ++j) { amax = fmaxf(amax, fmaxf(fmaxf(fabsf(bflo(w[j].x)), fabsf(bfhi(w[j].x))), fmaxf(fabsf(bflo(w[j].y)), fabsf(bfhi(w[j].y)))));
                                          amax = fmaxf(amax, fmaxf(fmaxf(fabsf(bflo(w[j].z)), fabsf(bfhi(w[j].z))), fmaxf(fabsf(bflo(w[j].w)), fabsf(bfhi(w[j].w))))); }
            amax = wave_max(amax); const float sc = amax > 0.f ? 127.0f / amax : 0.f;
#pragma unroll
            for (int j = 0; j < 8; ++j) { u32x2v o; o.x = q8x4(bflo(w[j].x) * sc, bfhi(w[j].x) * sc, bflo(w[j].y) * sc, bfhi(w[j].y) * sc); o.y = q8x4(bflo(w[j].z) * sc, bfhi(w[j].z) * sc, bflo(w[j].w) * sc, bfhi(w[j].w) * sc);
                *(GAS u32x2v*)(XQ + (size_t)m * DM + 8 * lane + 512 * j) = o; }
            if (lane == 0) RSTD[m] = amax * (1.0f / 127.0f) * rstd;
        }
        for (int m = MREAL + gw; m < MP; m += NGW) {
            if (m < MTOK) { const int r = m - MREAL; float ss = 0.f, amax = 0.f;
#pragma unroll 2
                for (int j = 0; j < 8; ++j) { const int col = 8 * lane + 512 * j; const GAS f32x4* mp = (const GAS f32x4*)(meta + (size_t)(r & 15) * DM + col); f32x4 a = mp[0], b = mp[1];
#pragma unroll
                    for (int ks = 0; ks < 16; ++ks) { const GAS f32x4* pp = (const GAS f32x4*)(PART + ((size_t)ks * 96 + r) * DM + col); a += pp[0]; b += pp[1]; }
                    GAS f32x4* xo = (GAS f32x4*)(X1M + (size_t)r * DM + col); xo[0] = a; xo[1] = b;
                    ss += (a.x * a.x + a.y * a.y) + (a.z * a.z + a.w * a.w) + (b.x * b.x + b.y * b.y) + (b.z * b.z + b.w * b.w);
                    v4u o; o.x = cvtpk(a.x, a.y); o.y = cvtpk(a.z, a.w); o.z = cvtpk(b.x, b.y); o.w = cvtpk(b.z, b.w); *(GAS v4u*)(XN + (size_t)m * DM + col) = o;
                    amax = fmaxf(amax, fmaxf(fmaxf(fabsf(bflo(o.x)), fabsf(bfhi(o.x))), fmaxf(fabsf(bflo(o.y)), fabsf(bfhi(o.y)))));
                    amax = fmaxf(amax, fmaxf(fmaxf(fabsf(bflo(o.z)), fabsf(bfhi(o.z))), fmaxf(fabsf(bflo(o.w)), fabsf(bfhi(o.w))))); }
                const float rr = 1.0f / sqrtf(wave_sum(ss) * (1.0f / 4096.0f) + EPS);
                amax = wave_max(amax); const float sc = amax > 0.f ? 127.0f / amax : 0.f;
#pragma unroll 2
                for (int j = 0; j < 8; ++j) { const int col = 8 * lane + 512 * j; const v4u w = *(const GAS v4u*)(XN + (size_t)m * DM + col);
                    u32x2v o; o.x = q8x4(bflo(w.x) * sc, bfhi(w.x) * sc, bflo(w.y) * sc, bfhi(w.y) * sc); o.y = q8x4(bflo(w.z) * sc, bfhi(w.z) * sc, bflo(w.w) * sc, bfhi(w.w) * sc);
                    *(GAS u32x2v*)(XQ + (size_t)m * DM + col) = o; }
                if (lane == 0) RSTD[m] = amax * (1.0f / 127.0f) * rr; }
            else {
#pragma unroll
                for (int j = 0; j < 8; ++j) *(GAS u32x2v*)(XQ + (size_t)m * DM + 8 * lane + 512 * j) = (u32x2v){0u, 0u};
                if (lane == 0) RSTD[m] = 0.f; }
        }
    }
    SEAM(7);
    if (IN(8)) REP(8) {
        pg8::Gemm g{(const bf16*)XQ, (const bf16*)WU, MP, NUP, DM / 2}; pg8::StaticOrder S; S.init(MP, NUP, G, bid);
        pg8::EpiUpFused E{HB, RSTD, CS, fcw, fcb, EP, EG, EU, EGM, (LAS float*)(lds + RING_BYTES + 4096)};
        pg8::gemm_phase<pg8::EpiUpFused, pg8::StaticOrder, true, true, 0, true>(lds, g, S, E);
#if PROBE_PHASE >= 70 && PROBE_PHASE <= 89
        { pg8::EpiNull EN; pg8::gemm_phase<pg8::EpiNull, pg8::StaticOrder, true, true, PROBE_PHASE - 70>(lds, g, S, EN); }
#endif
    }
    SEAM(8);
    if (IN(9)) REP(9) {
        for (int q = bid * 512 + tid; q < 128 * 1376; q += G * 512) fixup_item(q, EP, EG, EU, EGM, fcw, HB);
    }
    SEAM(9);
    if (IN(10)) REP(10) {
        pg8::Gemm g{HB, WD, MREAL, DM, DFF}; pg8::StaticOrder S; S.init(MREAL, DM, G, bid);
        pg8::EpiDown E{XN};
        pg8::gemm_phase<pg8::EpiDown, pg8::StaticOrder, true, true>(lds, g, S, E);
    }
    SEAM(10);
    if (IN(11)) REP(11) {
        for (int m = gw; m < MREAL; m += NGW) {
            float v[8][8]; float s = 0.f;
#pragma unroll
            for (int j = 0; j < 8; ++j) { const v4u w = *(const GAS v4u*)(XN + (size_t)m * DM + 8 * lane + 512 * j);
                v[j][0] = bflo(w.x); v[j][1] = bfhi(w.x); v[j][2] = bflo(w.y); v[j][3] = bfhi(w.y); v[j][4] = bflo(w.z); v[j][5] = bfhi(w.z); v[j][6] = bflo(w.w); v[j][7] = bfhi(w.w);
#pragma unroll
                for (int e = 0; e < 8; ++e) s += v[j][e] * v[j][e]; }
            const float rstd = 1.0f / sqrtf(wave_sum(s) * (1.0f / 4096.0f) + EPS);
#pragma unroll
            for (int j = 0; j < 8; ++j) { const GAS f32x4* gp = (const GAS f32x4*)(fin_g + 8 * lane + 512 * j); const f32x4 g0 = gp[0], g1 = gp[1];
                GAS f32x4* op = (GAS f32x4*)(out + (size_t)m * DM + 8 * lane + 512 * j);
                op[0] = (f32x4){v[j][0] * rstd * g0.x, v[j][1] * rstd * g0.y, v[j][2] * rstd * g0.z, v[j][3] * rstd * g0.w};
                op[1] = (f32x4){v[j][4] * rstd * g1.x, v[j][5] * rstd * g1.y, v[j][6] * rstd * g1.z, v[j][7] * rstd * g1.w}; } }
    }
#undef IN
#undef SEAM
}

extern "C" void kernel_launch(void* const* d_in, const int* in_sizes, int n_in, void* d_out, int out_size, void* d_ws, size_t ws_size, hipStream_t stream) {
    static int grid = 0;
    if (grid == 0) {
        if (n_in != 16 || ws_size < WS_END) { fprintf(stderr, "kernel_launch: unexpected n_in %d / ws_size %zu (need %zu)\n", n_in, ws_size, (size_t)WS_END); grid = -1; return; }
        int dev = 0, cus = 0, per_cu = 0;
        if (hipGetDevice(&dev) != hipSuccess || hipDeviceGetAttribute(&cus, hipDeviceAttributeMultiprocessorCount, dev) != hipSuccess) { grid = -1; return; }
        if (hipFuncSetAttribute((const void*)fwd, hipFuncAttributeMaxDynamicSharedMemorySize, LDS_BYTES) != hipSuccess) { fprintf(stderr, "kernel_launch: hipFuncSetAttribute failed\n"); grid = -1; return; }
        if (hipOccupancyMaxActiveBlocksPerMultiprocessor(&per_cu, (const void*)fwd, NWAVES * 64, LDS_BYTES) != hipSuccess || per_cu < 1) { fprintf(stderr, "kernel_launch: occupancy query says %d\n", per_cu); }
        (void)hipGetLastError();
        grid = cus;
    }
    if (grid < 0) return;
    (void)hipMemsetAsync((char*)d_ws + WS_CTL, 0, CTL_ZERO_BYTES, stream);
    Args a{};
    for (int i = 0; i < 16; ++i) a.in[i] = (const float*)d_in[i];
    a.out = (float*)d_out; a.ws = (unsigned char*)d_ws;
#if MK_ONE_LAUNCH
    a.ph_lo = 0; a.ph_hi = NPHASE;
    hipLaunchKernelGGL(fwd, dim3(grid), dim3(NWAVES * 64), LDS_BYTES, stream, a);
#else
    for (int p = 0; p < NPHASE; ++p) { a.ph_lo = p; a.ph_hi = p + 1; hipLaunchKernelGGL(fwd, dim3(grid), dim3(NWAVES * 64), LDS_BYTES, stream, a); }
#endif
}
```

```cpp
#include <hip/hip_runtime.h>
#include <cstdio>
#include <cstdint>
namespace pg8 {
#define PG8_LAS __attribute__((address_space(3)))
typedef unsigned short bf16_t;
typedef short bf16x8 __attribute__((ext_vector_type(8)));
typedef float f32x4 __attribute__((ext_vector_type(4)));
typedef unsigned u32x4 __attribute__((ext_vector_type(4)));
typedef unsigned u32x2 __attribute__((ext_vector_type(2)));
typedef int i32x4 __attribute__((ext_vector_type(4)));
constexpr int BM = 256, BK = 64, HALF = 128, HTB = HALF * BK * 2  , STAGE_BYTES = 8 * HTB, NXCD = 8, WGM = 8;

__host__ __device__ __forceinline__ int lds_byte(int r, int c) { const int st = (r >> 4) * 2 + (c >> 5), rr = r & 15, cc = c & 31, ob = rr * 64 + cc * 2; return st * 1024 + (ob ^ (((ob >> 9) & 1) << 5)); }
__host__ __device__ __forceinline__ void stage_rc(int b, int& R, int& C) { const int st = b / 1024, sb = b % 1024, swz = sb ^ (((sb >> 9) & 1) << 5); R = (st >> 1) * 16 + swz / 64; C = (st & 1) * 32 + (swz % 64) / 2; }
__host__ __device__ __forceinline__ int perm32(int rho) { const int n = rho >> 4, i = rho & 15; return 8 * (i >> 2) + 4 * n + (i & 3); }

struct Unit { int pm, pn; int ks = 0; };
struct Gemm { const bf16_t* A; const bf16_t* Bt; int M, N, K; int ld = 0; };

struct StaticOrder {
    int nM, nN, nwg, G, c;
    __host__ __device__ void init(int M, int N, int G_, int c_) { nM = M / BM; nN = N / BM; nwg = nM * nN; G = G_; c = c_; }
    __host__ __device__ bool next(int i, Unit& u) const {
        const long L = (long)i * G + c; if (L >= nwg) return false;
        int wgid = (int)L; { const int q = nwg / NXCD, r = nwg % NXCD, xcd = wgid % NXCD, off = wgid / NXCD; wgid = (xcd < r ? xcd * (q + 1) : r * (q + 1) + (xcd - r) * q) + off; }
        const int nig = WGM * nN, gid = wgid / nig, fm = gid * WGM, gsz = (nM - fm) < WGM ? (nM - fm) : WGM;
        u.pm = fm + ((wgid % nig) % gsz); u.pn = (wgid % nig) / gsz; return true;
    }
    __device__ __forceinline__ void a_ready(const Unit&) const {}
    __device__ __forceinline__ void done(const Unit&) const {}
};

typedef float f32x2_t __attribute__((ext_vector_type(2))); typedef __bf16 bf16x2_t __attribute__((ext_vector_type(2)));
__device__ __forceinline__ unsigned cvt_pk_bf16(float lo, float hi) { const f32x2_t v = {lo, hi}; const bf16x2_t b = __builtin_convertvector(v, bf16x2_t); return __builtin_bit_cast(unsigned, b); }
typedef float f32x2 __attribute__((ext_vector_type(2)));
struct EpiIn {
    static constexpr bool PERM = true, AFTER_DRAIN = false;
    bf16_t *PQK, *PV, *PR, *PC; float* AD; int pn_off;
    __device__ __forceinline__ void operator()(const f32x4 (&acc)[2][2][4][2], const Unit& u, int wr, int wc, int fr, int fq) const {
        const int row0 = u.pm * BM + wr * 64 + fr; const int pn = u.pn + pn_off;
        if (pn < 32) {
            bf16_t* base; int ldc, colt;
            if (pn < 8) { base = PV; ldc = 2048; colt = pn * 256; }
            else if (pn < 16) { base = PR; ldc = 2048; colt = (pn - 8) * 256; }
            else if (pn < 24) { base = PQK; ldc = 2048; colt = (pn - 16) * 256; }
            else { base = PC; ldc = 4096; colt = (pn - 24) * 256; }
            const int col0 = colt + wc * 32 + 8 * fq;
#pragma unroll
            for (int ai = 0; ai < 2; ++ai)
#pragma unroll
                for (int m = 0; m < 4; ++m) { bf16_t* rowp = base + (size_t)(row0 + ai * HALF + m * 16) * ldc + col0;
#pragma unroll
                    for (int bj = 0; bj < 2; ++bj) { const f32x4 v0 = acc[ai][bj][m][0], v1 = acc[ai][bj][m][1];
                        u32x4 w; w.x = cvt_pk_bf16(v0[0], v0[1]); w.y = cvt_pk_bf16(v0[2], v0[3]); w.z = cvt_pk_bf16(v1[0], v1[1]); w.w = cvt_pk_bf16(v1[2], v1[3]);
                        *(u32x4*)(rowp + bj * HALF) = w; } }
        } else if (pn < 48) {
            const int col0 = 2048 + (pn - 32) * 128 + wc * 32 + 8 * fq;
#pragma unroll
            for (int ai = 0; ai < 2; ++ai)
#pragma unroll
                for (int m = 0; m < 4; ++m) { bf16_t* rowp = PC + (size_t)(row0 + ai * HALF + m * 16) * 4096 + col0;
                    const f32x4 v0 = acc[ai][0][m][0] * acc[ai][1][m][0], v1 = acc[ai][0][m][1] * acc[ai][1][m][1];
                    u32x4 w; w.x = cvt_pk_bf16(v0[0], v0[1]); w.y = cvt_pk_bf16(v0[2], v0[3]); w.z = cvt_pk_bf16(v1[0], v1[1]); w.w = cvt_pk_bf16(v1[2], v1[3]);
                    *(u32x4*)rowp = w; }
        } else if (wc == 0) {
#pragma unroll
            for (int ai = 0; ai < 2; ++ai)
#pragma unroll
                for (int m = 0; m < 4; ++m) { float* rowp = AD + (size_t)(row0 + ai * HALF + m * 16) * 32 + 8 * fq;
#pragma unroll
                    for (int n = 0; n < 2; ++n) *(f32x4*)(rowp + 4 * n) = acc[ai][0][m][n]; }
        }
    }
};
struct EpiIn8 {
    static constexpr bool PERM = true, AFTER_DRAIN = false;
    bf16_t *PQK, *PV, *PR; const float* RF; const float* CM;
    __device__ __forceinline__ void operator()(const f32x4 (&acc)[2][2][4][2], const Unit& u, int wr, int wc, int fr, int fq) const {
        const int row0 = u.pm * BM + wr * 64 + fr; const int pn = u.pn;
        bf16_t* base; int colt;
        if (pn < 8) { base = PV; colt = pn * 256; } else if (pn < 16) { base = PR; colt = (pn - 8) * 256; } else { base = PQK; colt = (pn - 16) * 256; }
        const int col0 = colt + wc * 32 + 8 * fq;
        f32x4 cf[2][2];
#pragma unroll
        for (int bj = 0; bj < 2; ++bj)
#pragma unroll
            for (int n = 0; n < 2; ++n) cf[bj][n] = *(const f32x4*)(CM + pn * 256 + bj * HALF + wc * 32 + 8 * fq + 4 * n) * (1.05f / 127.0f);
#pragma unroll
        for (int ai = 0; ai < 2; ++ai)
#pragma unroll
            for (int m = 0; m < 4; ++m) { const int row = row0 + ai * HALF + m * 16; const float rf = RF[row]; bf16_t* rowp = base + (size_t)row * 2048 + col0;
#pragma unroll
                for (int bj = 0; bj < 2; ++bj) { const f32x4 v0 = __builtin_convertvector(__builtin_bit_cast(i32x4, acc[ai][bj][m][0]), f32x4) * (cf[bj][0] * rf), v1 = __builtin_convertvector(__builtin_bit_cast(i32x4, acc[ai][bj][m][1]), f32x4) * (cf[bj][1] * rf);
                    u32x4 w; w.x = cvt_pk_bf16(v0[0], v0[1]); w.y = cvt_pk_bf16(v0[2], v0[3]); w.z = cvt_pk_bf16(v1[0], v1[1]); w.w = cvt_pk_bf16(v1[2], v1[3]);
                    *(u32x4*)(rowp + bj * HALF) = w; } }
    }
};
struct EpiBf16Plain {
    static constexpr bool PERM = true, AFTER_DRAIN = false;
    bf16_t* O; int ldc;
    __device__ __forceinline__ void operator()(const f32x4 (&acc)[2][2][4][2], const Unit& u, int wr, int wc, int fr, int fq) const {
        const int row0 = u.pm * BM + wr * 64 + fr, col0 = u.pn * BM + wc * 32 + 8 * fq;
#pragma unroll
        for (int ai = 0; ai < 2; ++ai)
#pragma unroll
            for (int m = 0; m < 4; ++m) { bf16_t* rowp = O + (size_t)(row0 + ai * HALF + m * 16) * ldc + col0;
#pragma unroll
                for (int bj = 0; bj < 2; ++bj) { const f32x4 v0 = acc[ai][bj][m][0], v1 = acc[ai][bj][m][1];
                    u32x4 w; w.x = cvt_pk_bf16(v0[0], v0[1]); w.y = cvt_pk_bf16(v0[2], v0[3]); w.z = cvt_pk_bf16(v1[0], v1[1]); w.w = cvt_pk_bf16(v1[2], v1[3]);
                    *(u32x4*)(rowp + bj * HALF) = w; } }
    }
};
struct EpiOut {
    static constexpr bool PERM = false, AFTER_DRAIN = false;
    const float *xp, *xs; bf16_t* XN; float* SSQ;
    __device__ __forceinline__ void operator()(f32x4 (&acc)[2][2][4][2], const Unit& u, int wr, int wc, int fr, int fq) const {
        const int row0 = u.pm * BM + wr * 64 + fr, col0 = u.pn * BM + wc * 32 + 4 * fq;
#pragma unroll
        for (int ai = 0; ai < 2; ++ai)
#pragma unroll
            for (int m = 0; m < 4; ++m) { const int row = row0 + ai * HALF + m * 16; float ss = 0.f;
                const float* src = row < 8192 ? xp + (size_t)row * 4096 : xs + (size_t)(row - 8192) * 4096; bf16_t* xb = XN + (size_t)row * 4096;
#pragma unroll
                for (int bj = 0; bj < 2; ++bj)
#pragma unroll
                    for (int n = 0; n < 2; ++n) { const int off = col0 + bj * HALF + n * 16; const f32x4 v = *(const f32x4*)(src + off) + acc[ai][bj][m][n];
                        ss += (v[0] * v[0] + v[1] * v[1]) + (v[2] * v[2] + v[3] * v[3]);
                        u32x2 w; w.x = cvt_pk_bf16(v[0], v[1]); w.y = cvt_pk_bf16(v[2], v[3]); *(u32x2*)(xb + off) = w; }
                ss += __shfl_xor(ss, 16); ss += __shfl_xor(ss, 32);
                if (fq == 0) SSQ[(size_t)row * 64 + u.pn * 4 + wc] = ss; }
    }
};
struct EpiPart {
    static constexpr bool PERM = false, AFTER_DRAIN = false;
    float* PART;
    __device__ __forceinline__ void operator()(f32x4 (&acc)[2][2][4][2], const Unit& u, int wr, int wc, int fr, int fq) const {
        const int col0 = u.pn * BM + wc * 32 + 4 * fq;
#pragma unroll
        for (int m = 0; m < 4; ++m) { const int row = wr * 64 + m * 16 + fr;
            if (row < 96) { float* dst = PART + ((size_t)u.ks * 96 + row) * 4096 + col0;
#pragma unroll
                for (int bj = 0; bj < 2; ++bj)
#pragma unroll
                    for (int n = 0; n < 2; ++n) *(f32x4*)(dst + bj * HALF + n * 16) = acc[0][bj][m][n]; } }
    }
};
struct MiniOrder {
    int pm, ncol, nks, G, c;
    __device__ bool next(int i, Unit& u) const { const int j = i * G + c; if (j >= ncol * nks) return false; u.pm = pm; u.pn = j % ncol; u.ks = j / ncol; return true; }
    __device__ __forceinline__ void a_ready(const Unit&) const {}
    __device__ __forceinline__ void done(const Unit&) const {}
};
struct EpiDown {
    static constexpr bool PERM = false, AFTER_DRAIN = false;
    bf16_t* X;
    __device__ __forceinline__ void operator()(f32x4 (&acc)[2][2][4][2], const Unit& u, int wr, int wc, int fr, int fq) const {
        const int row0 = u.pm * BM + wr * 64 + fr, col0 = u.pn * BM + wc * 32 + 4 * fq;
#pragma unroll
        for (int ai = 0; ai < 2; ++ai)
#pragma unroll
            for (int m = 0; m < 4; ++m) { bf16_t* rowp = X + (size_t)(row0 + ai * HALF + m * 16) * 4096 + col0;
#pragma unroll
                for (int bj = 0; bj < 2; ++bj)
#pragma unroll
                    for (int n = 0; n < 2; ++n) { bf16_t* p = rowp + bj * HALF + n * 16; const u32x2 w = *(const u32x2*)p; const f32x4 a = acc[ai][bj][m][n];
                        u32x2 o; o.x = cvt_pk_bf16(__builtin_bit_cast(float, w.x << 16) + a[0], __builtin_bit_cast(float, w.x & 0xffff0000u) + a[1]);
                        o.y = cvt_pk_bf16(__builtin_bit_cast(float, w.y << 16) + a[2], __builtin_bit_cast(float, w.y & 0xffff0000u) + a[3]); *(u32x2*)p = o; } }
    }
};

struct EpiNull {
    static constexpr bool PERM = true, AFTER_DRAIN = false;
    __device__ __forceinline__ void operator()(const f32x4 (&acc)[2][2][4][2], const Unit& u, int wr, int wc, int fr, int fq) const {
#pragma unroll
        for (int ai = 0; ai < 2; ++ai)
#pragma unroll
            for (int bj = 0; bj < 2; ++bj)
#pragma unroll
                for (int m = 0; m < 4; ++m)
#pragma unroll
                    for (int n = 0; n < 2; ++n) asm volatile("" :: "v"(acc[ai][bj][m][n]));
    }
};
struct EpiUpFused {
    static constexpr bool PERM = true, AFTER_DRAIN = false;
    bf16_t* H; const float* RSTD; const float* CS; const float* cw; const float* cb; float *EP, *EG, *EU, *EGM; PG8_LAS float* halo;
    __device__ __forceinline__ void operator()(f32x4 (&acc)[2][2][4][2], const Unit& u, int wr, int wc, int fr, int fq) const {
        const int lane = fq * 16 + fr, ft = wc * 32 + 8 * fq, f0 = u.pn * 128 + ft;
        float rs[2][4]; f32x4 su[2], sg[2];
#pragma unroll
        for (int ai = 0; ai < 2; ++ai)
#pragma unroll
            for (int m = 0; m < 4; ++m) rs[ai][m] = RSTD[u.pm * BM + ai * HALF + wr * 64 + m * 16 + fr];
#pragma unroll
        for (int n = 0; n < 2; ++n) { su[n] = *(const f32x4*)(CS + f0 + 4 * n); sg[n] = *(const f32x4*)(CS + 11008 + f0 + 4 * n); }
#pragma unroll
        for (int ai = 0; ai < 2; ++ai)
#pragma unroll
            for (int m = 0; m < 4; ++m)
#pragma unroll
                for (int n = 0; n < 2; ++n) {
                    acc[ai][1][m][n] = __builtin_convertvector(__builtin_bit_cast(i32x4, acc[ai][1][m][n]), f32x4) * (sg[n] * rs[ai][m]);
                    acc[ai][0][m][n] = __builtin_convertvector(__builtin_bit_cast(i32x4, acc[ai][0][m][n]), f32x4) * (su[n] * rs[ai][m]); }
        if (fr == 0) {
#pragma unroll
            for (int ai = 0; ai < 2; ++ai)
#pragma unroll
                for (int n = 0; n < 2; ++n) *(PG8_LAS f32x4*)(halo + (2 * ai + wr) * 128 + ft + 4 * n) = acc[ai][1][0][n]; }
        if (fr == 15) {
#pragma unroll
            for (int ai = 0; ai < 2; ++ai)
#pragma unroll
                for (int n = 0; n < 2; ++n) *(PG8_LAS f32x4*)(halo + (4 + 2 * ai + wr) * 128 + ft + 4 * n) = acc[ai][1][3][n]; }
        asm volatile("s_waitcnt lgkmcnt(0)" ::: "memory"); __builtin_amdgcn_s_barrier(); asm volatile("" ::: "memory");
        f32x4 w0[2], w1[2], w2[2], bb[2];
#pragma unroll
        for (int n = 0; n < 2; ++n) { w0[n] = *(const f32x4*)(cw + f0 + 4 * n); w1[n] = *(const f32x4*)(cw + 11008 + f0 + 4 * n); w2[n] = *(const f32x4*)(cw + 22016 + f0 + 4 * n); bb[n] = *(const f32x4*)(cb + f0 + 4 * n); }
        const int srcp = (lane & 48) | ((lane - 1) & 15), srcn = (lane & 48) | ((lane + 1) & 15);
        const bool meta_tile = (u.pm == 64);
#pragma unroll
        for (int ai = 0; ai < 2; ++ai) {
            f32x4 hp[2], hn[2];
            const bool has_p = !(ai == 0 && wr == 0), has_n = !(ai == 1 && wr == 1);
            const int sp = (wr == 1) ? 4 + 2 * ai : 4 + 1, sn = (wr == 0) ? 2 * ai + 1 : 2;
#pragma unroll
            for (int n = 0; n < 2; ++n) { hp[n] = has_p ? *(const PG8_LAS f32x4*)(halo + sp * 128 + ft + 4 * n) : (f32x4){0.f, 0.f, 0.f, 0.f};
                                          hn[n] = has_n ? *(const PG8_LAS f32x4*)(halo + sn * 128 + ft + 4 * n) : (f32x4){0.f, 0.f, 0.f, 0.f}; }
#pragma unroll
            for (int m = 0; m < 4; ++m) { const int rl = ai * HALF + wr * 64 + m * 16 + fr;
                f32x4 hv[2], gcs[2];
#pragma unroll
                for (int n = 0; n < 2; ++n) { const f32x4 gc = acc[ai][1][m][n]; gcs[n] = gc;
                    f32x4 tp = gc, tn = gc;
                    if (m > 0) { if (fr == 15) tp = acc[ai][1][m - 1][n]; }
                    if (m < 3) { if (fr == 0) tn = acc[ai][1][m + 1][n]; }
                    f32x4 gp, gn;
#pragma unroll
                    for (int j = 0; j < 4; ++j) { gp[j] = __shfl(tp[j], srcp); gn[j] = __shfl(tn[j], srcn); }
                    if (m == 0) { if (fr == 0) gp = hp[n]; }
                    if (m == 3) { if (fr == 15) gn = hn[n]; }
                    const f32x4 pre = w0[n] * gp + w1[n] * gc + w2[n] * gn + bb[n];
                    hv[n] = pre; }
                const bool edge0 = (rl == 0), edge1 = (rl == 255);
                if (meta_tile) {
                    if (ai == 0 && fr == 15 && rl < 96) { float* d = EGM + (size_t)(rl >> 4) * 11008 + f0; *(f32x4*)d = gcs[0]; *(f32x4*)(d + 4) = gcs[1]; }
                } else if (edge0 || edge1) { const size_t eo = ((size_t)u.pm * 2 + (edge1 ? 1 : 0)) * 11008 + f0;
                    *(f32x4*)(EP + eo) = hv[0]; *(f32x4*)(EP + eo + 4) = hv[1]; *(f32x4*)(EG + eo) = gcs[0]; *(f32x4*)(EG + eo + 4) = gcs[1];
                    *(f32x4*)(EU + eo) = acc[ai][0][m][0]; *(f32x4*)(EU + eo + 4) = acc[ai][0][m][1];
                } else { float o[8];
#pragma unroll
                    for (int n = 0; n < 2; ++n)
#pragma unroll
                        for (int j = 0; j < 4; ++j) { const float p = hv[n][j]; o[4 * n + j] = p * __builtin_amdgcn_rcpf(1.0f + __builtin_amdgcn_exp2f(-1.4426950408889634f * p)) * acc[ai][0][m][n][j]; }
                    u32x4 w; w.x = cvt_pk_bf16(o[0], o[1]); w.y = cvt_pk_bf16(o[2], o[3]); w.z = cvt_pk_bf16(o[4], o[5]); w.w = cvt_pk_bf16(o[6], o[7]);
                    *(u32x4*)(H + (size_t)(u.pm * BM + rl) * 11008 + f0) = w; } } }
    }
};
template <bool I8> __device__ __forceinline__ f32x4 mma16(const bf16x8 b, const bf16x8 a, const f32x4 c) {
    if constexpr (I8) return __builtin_bit_cast(f32x4, __builtin_amdgcn_mfma_i32_16x16x64_i8(__builtin_bit_cast(i32x4, b), __builtin_bit_cast(i32x4, a), __builtin_bit_cast(i32x4, c), 0, 0, 0));
    else return __builtin_amdgcn_mfma_f32_16x16x32_bf16(b, a, c, 0, 0, 0);
}
template <class Epi, class Sched, bool ALIGN_EPI = false, bool SP2 = false, int VAR = 0, bool I8 = false>
__device__ __forceinline__ void gemm_phase(PG8_LAS unsigned char* lds, const Gemm g, const Sched& S, const Epi& E) {
    const int tid = threadIdx.x, wid = __builtin_amdgcn_readfirstlane(tid >> 6), lane = tid & 63, wr = wid >> 2, wc = wid & 3, fr = lane & 15, fq = lane >> 4;
    const int K = g.K, nt = K / BK, ld = g.ld ? g.ld : g.K;
    unsigned voffA[2], voffB[2];
#pragma unroll
    for (int i = 0; i < 2; ++i) { int R, C; stage_rc(tid * 16 + i * 8192, R, C); const int Rb = Epi::PERM ? ((R & ~31) + perm32(R & 31)) : R;
        voffA[i] = (unsigned)(R * ld + C) * 2u; voffB[i] = (unsigned)(Rb * ld + C) * 2u; }
    const size_t kstep = (VAR == 1) ? (size_t)0 : (size_t)(BK * 2);
    const size_t hstep = (size_t)HALF * ld * 2;
    const size_t tstep = 2 * hstep;
    const unsigned ldsw = (unsigned)wid * 1024u;
    const int aoff = (VAR == 6) ? lane * 16 : lds_byte(wr * 64 + fr, fq * 8), boff = (VAR == 6) ? lane * 16 : lds_byte(wc * 32 + fr, fq * 8);
#define PG8_SA(b, h) (((b) * 2 + (h)) * HTB)
#define PG8_SB(b, h) ((4 + (b) * 2 + (h)) * HTB)
#define PG8_STAGE(bufoff, gbase, voff) do { if (VAR != 3 && VAR != 4) _Pragma("unroll") for (int _i = 0; _i < 2; ++_i) \
        __builtin_amdgcn_global_load_lds((const unsigned*)((const char*)(gbase) + (voff)[_i]), (PG8_LAS unsigned*)(lds + (bufoff) + ldsw + _i * 8192), 16, 0, 0); } while (0)
#define PG8_LDA(dst, b, h) do { if (VAR != 4) _Pragma("unroll") for (int m = 0; m < 4; ++m) _Pragma("unroll") for (int k = 0; k < 2; ++k) dst[m][k] = *(const PG8_LAS bf16x8*)(lds + PG8_SA(b, h) + aoff + m * 2048 + k * 1024); } while (0)
#define PG8_LDB(dst, b, h) do { if (VAR != 4) _Pragma("unroll") for (int n = 0; n < 2; ++n) _Pragma("unroll") for (int k = 0; k < 2; ++k) dst[n][k] = *(const PG8_LAS bf16x8*)(lds + PG8_SB(b, h) + boff + n * 2048 + k * 1024); } while (0)
#define PG8_MMA(ai, bj, At, Bt) do { if (VAR == 11) __builtin_amdgcn_s_setprio(3); else if (VAR != 8 && VAR != 9) __builtin_amdgcn_s_setprio(1); if (VAR != 2) _Pragma("unroll") for (int m = 0; m < 4; ++m) _Pragma("unroll") for (int n = 0; n < 2; ++n) _Pragma("unroll") for (int k = 0; k < 2; ++k) \
        acc[ai][bj][m][n] = mma16<I8>(Bt[n][k], At[m][k], acc[ai][bj][m][n]); if (VAR == 10) __builtin_amdgcn_s_setprio(2); else if (VAR == 11) __builtin_amdgcn_s_setprio(1); else if (VAR != 8 && VAR != 9) __builtin_amdgcn_s_setprio(0); } while (0)
#define PG8_WAIT_V(n) asm volatile("s_waitcnt vmcnt(" #n ")" ::: "memory")
#define PG8_WAIT_L(n) asm volatile("s_waitcnt lgkmcnt(" #n ")" ::: "memory")
#define PG8_BAR __builtin_amdgcn_s_barrier()
#define PG8_SCHED __builtin_amdgcn_sched_barrier(0)
    Unit cur, nxt; int ui = 0;
    if (VAR == 9) { if (wr == 1) __builtin_amdgcn_s_setprio(1); }
    if (!S.next(0, cur)) return;
    f32x4 acc[2][2][4][2];
#pragma unroll
    for (int a = 0; a < 2; ++a)
#pragma unroll
        for (int b = 0; b < 2; ++b)
#pragma unroll
            for (int m = 0; m < 4; ++m)
#pragma unroll
                for (int n = 0; n < 2; ++n) acc[a][b][m][n] = (f32x4){0.f, 0.f, 0.f, 0.f};
    bf16x8 At[4][2], B0[2][2], B1[2][2];
    if (VAR == 4) { const short sv = (short)(0x3c00 + tid);
#pragma unroll
        for (int m = 0; m < 4; ++m) for (int k = 0; k < 2; ++k) { At[m][k] = (bf16x8){sv, sv, sv, sv, sv, sv, sv, sv}; asm volatile("" : "+v"(At[m][k])); }
#pragma unroll
        for (int n = 0; n < 2; ++n) for (int k = 0; k < 2; ++k) { B0[n][k] = (bf16x8){sv, sv, sv, sv, sv, sv, sv, sv}; B1[n][k] = B0[n][k]; asm volatile("" : "+v"(B0[n][k])); asm volatile("" : "+v"(B1[n][k])); } }
    const char* cA = (const char*)g.A + (size_t)cur.pm * tstep + (size_t)cur.ks * K * 2; const char* cB = (const char*)g.Bt + (size_t)cur.pn * tstep + (size_t)cur.ks * K * 2;
    S.a_ready(cur);
    if constexpr (SP2) {
        PG8_STAGE(PG8_SB(0, 0), cB, voffB); PG8_STAGE(PG8_SB(0, 1), cB + hstep, voffB); PG8_STAGE(PG8_SA(0, 0), cA, voffA); PG8_STAGE(PG8_SA(0, 1), cA + hstep, voffA);
        if (wr == 1) PG8_BAR;
        PG8_WAIT_V(2); PG8_BAR;
        PG8_STAGE(PG8_SB(1, 0), cB + kstep, voffB); PG8_STAGE(PG8_SA(1, 0), cA + kstep, voffA); PG8_STAGE(PG8_SB(1, 1), cB + hstep + kstep, voffB);
        PG8_WAIT_V(6); PG8_BAR;
    } else {
        PG8_STAGE(PG8_SB(0, 0), cB, voffB); PG8_STAGE(PG8_SA(0, 0), cA, voffA); PG8_STAGE(PG8_SB(0, 1), cB + hstep, voffB); PG8_STAGE(PG8_SA(0, 1), cA + hstep, voffA);
        if (wr == 1) PG8_BAR;
        PG8_WAIT_V(4); PG8_BAR;
        PG8_STAGE(PG8_SB(1, 0), cB + kstep, voffB); PG8_STAGE(PG8_SA(1, 0), cA + kstep, voffA); PG8_STAGE(PG8_SB(1, 1), cB + hstep + kstep, voffB);
        PG8_WAIT_V(6); PG8_BAR;
    }
    for (;;) {
        const bool has_next = S.next(ui + 1, nxt);
        const char* nA = has_next ? (const char*)g.A + (size_t)nxt.pm * tstep + (size_t)nxt.ks * K * 2 : cA; const char* nB = has_next ? (const char*)g.Bt + (size_t)nxt.pn * tstep + (size_t)nxt.ks * K * 2 : cB;
        for (int t = 0; t < nt; t += 2) {
            const bool last = (t == nt - 2);
            const char* a1 = cA + (size_t)(t + 1) * kstep;
            const char* a2 = last ? nA : cA + (size_t)(t + 2) * kstep; const char* b2 = last ? nB : cB + (size_t)(t + 2) * kstep;
            const char* a3 = a2 + kstep; const char* b3 = b2 + kstep;
            if (last && has_next) S.a_ready(nxt);
            if constexpr (SP2 && VAR == 5) {
            PG8_LDB(B0, 0, 0); PG8_LDB(B1, 0, 1); PG8_SCHED; PG8_LDA(At, 0, 0);
            PG8_WAIT_V(6); PG8_WAIT_L(0); PG8_BAR; PG8_MMA(0, 0, At, B0); PG8_SCHED; PG8_STAGE(PG8_SA(1, 1), a1 + hstep, voffA); PG8_SCHED; PG8_MMA(0, 1, At, B1); PG8_BAR; PG8_SCHED;
            PG8_LDA(At, 0, 1);
            PG8_WAIT_V(2); PG8_WAIT_L(0); PG8_BAR; PG8_MMA(1, 0, At, B0); PG8_SCHED; PG8_STAGE(PG8_SB(0, 0), b2, voffB); PG8_STAGE(PG8_SB(0, 1), b2 + hstep, voffB); PG8_STAGE(PG8_SA(0, 0), a2, voffA); PG8_SCHED; PG8_MMA(1, 1, At, B1); PG8_BAR; PG8_SCHED;
            PG8_LDB(B0, 1, 0); PG8_LDB(B1, 1, 1); PG8_SCHED; PG8_LDA(At, 1, 0);
            PG8_WAIT_V(6); PG8_WAIT_L(0); PG8_BAR; PG8_MMA(0, 0, At, B0); PG8_SCHED; PG8_STAGE(PG8_SA(0, 1), a2 + hstep, voffA); PG8_SCHED; PG8_MMA(0, 1, At, B1); PG8_BAR; PG8_SCHED;
            PG8_LDA(At, 1, 1);
            PG8_WAIT_V(2); PG8_WAIT_L(0); PG8_BAR; PG8_MMA(1, 0, At, B0); PG8_SCHED; PG8_STAGE(PG8_SB(1, 0), b3, voffB); PG8_STAGE(PG8_SB(1, 1), b3 + hstep, voffB); PG8_STAGE(PG8_SA(1, 0), a3, voffA); PG8_SCHED; PG8_MMA(1, 1, At, B1); PG8_BAR; PG8_SCHED;
            } else if constexpr (SP2) {
            PG8_LDB(B0, 0, 0); PG8_LDB(B1, 0, 1); PG8_SCHED; PG8_LDA(At, 0, 0); PG8_STAGE(PG8_SA(1, 1), a1 + hstep, voffA);
            PG8_WAIT_V(8); PG8_WAIT_L(0); PG8_BAR; PG8_MMA(0, 0, At, B0); PG8_MMA(0, 1, At, B1); PG8_BAR; PG8_SCHED;
            if (VAR != 7) PG8_LDA(At, 0, 1); PG8_STAGE(PG8_SB(0, 0), b2, voffB); PG8_STAGE(PG8_SB(0, 1), b2 + hstep, voffB); PG8_STAGE(PG8_SA(0, 0), a2, voffA);
            PG8_WAIT_V(8); PG8_WAIT_L(0); PG8_BAR; PG8_MMA(1, 0, At, B0); PG8_MMA(1, 1, At, B1); PG8_BAR; PG8_SCHED;
            PG8_LDB(B0, 1, 0); PG8_LDB(B1, 1, 1); PG8_SCHED; PG8_LDA(At, 1, 0); PG8_STAGE(PG8_SA(0, 1), a2 + hstep, voffA);
            PG8_WAIT_V(8); PG8_WAIT_L(0); PG8_BAR; PG8_MMA(0, 0, At, B0); PG8_MMA(0, 1, At, B1); PG8_BAR; PG8_SCHED;
            if (VAR != 7) PG8_LDA(At, 1, 1); PG8_STAGE(PG8_SB(1, 0), b3, voffB); PG8_STAGE(PG8_SB(1, 1), b3 + hstep, voffB); PG8_STAGE(PG8_SA(1, 0), a3, voffA);
            PG8_WAIT_V(8); PG8_WAIT_L(0); PG8_BAR; PG8_MMA(1, 0, At, B0); PG8_MMA(1, 1, At, B1); PG8_BAR; PG8_SCHED;
            } else {
            PG8_LDB(B0, 0, 0); PG8_SCHED; PG8_LDA(At, 0, 0); PG8_STAGE(PG8_SA(1, 1), a1 + hstep, voffA);
            PG8_WAIT_L(8); PG8_BAR; PG8_WAIT_L(0); PG8_MMA(0, 0, At, B0); PG8_BAR; PG8_SCHED;
            PG8_LDB(B1, 0, 1); PG8_STAGE(PG8_SB(0, 0), b2, voffB);
            PG8_BAR; PG8_WAIT_L(0); PG8_MMA(0, 1, At, B1); PG8_BAR;
            PG8_LDA(At, 0, 1); PG8_STAGE(PG8_SA(0, 0), a2, voffA);
            PG8_BAR; PG8_WAIT_L(0); PG8_MMA(1, 0, At, B0); PG8_BAR; PG8_SCHED;
            PG8_STAGE(PG8_SB(0, 1), b2 + hstep, voffB);
            PG8_WAIT_V(6); PG8_BAR; PG8_MMA(1, 1, At, B1); PG8_BAR;
            PG8_LDB(B0, 1, 0); PG8_SCHED; PG8_LDA(At, 1, 0); PG8_STAGE(PG8_SA(0, 1), a2 + hstep, voffA);
            PG8_WAIT_L(8); PG8_BAR; PG8_WAIT_L(0); PG8_MMA(0, 0, At, B0); PG8_BAR; PG8_SCHED;
            PG8_LDB(B1, 1, 1); PG8_STAGE(PG8_SB(1, 0), b3, voffB);
            PG8_BAR; PG8_WAIT_L(0); PG8_MMA(0, 1, At, B1); PG8_BAR;
            PG8_LDA(At, 1, 1); PG8_STAGE(PG8_SA(1, 0), a3, voffA);
            PG8_BAR; PG8_WAIT_L(0); PG8_MMA(1, 0, At, B0); PG8_BAR; PG8_SCHED;
            PG8_STAGE(PG8_SB(1, 1), b3 + hstep, voffB);
            PG8_WAIT_V(6); PG8_BAR; PG8_MMA(1, 1, At, B1); PG8_BAR;
            }
        }
        if constexpr (ALIGN_EPI) { if (wr == 0) PG8_BAR; }
        if constexpr (!Epi::AFTER_DRAIN) { E(acc, cur, wr, wc, fr, fq); S.done(cur); }
        if (!has_next) break;
#pragma unroll
        for (int a = 0; a < 2; ++a)
#pragma unroll
            for (int b = 0; b < 2; ++b)
#pragma unroll
                for (int m = 0; m < 4; ++m)
#pragma unroll
                    for (int n = 0; n < 2; ++n) acc[a][b][m][n] = (f32x4){0.f, 0.f, 0.f, 0.f};
        cur = nxt; cA = nA; cB = nB; ++ui;
        if constexpr (ALIGN_EPI) { if (wr == 1) PG8_BAR; }
    }
    PG8_WAIT_V(0);
    if constexpr (!ALIGN_EPI) { if (wr == 0) PG8_BAR; }
    PG8_BAR;
    if constexpr (Epi::AFTER_DRAIN) { E.fused(acc, cur, wr, wc, fr, fq, lds, wid, lane); S.done(cur); }
#undef PG8_SA
#undef PG8_SB
#undef PG8_STAGE
#undef PG8_LDA
#undef PG8_LDB
#undef PG8_MMA
#undef PG8_WAIT_V
#undef PG8_WAIT_L
#undef PG8_BAR
#undef PG8_SCHED
}
}
#define GAS __attribute__((address_space(1)))
#define LAS __attribute__((address_space(3)))
typedef unsigned short bf16;
typedef unsigned v4u __attribute__((ext_vector_type(4)));
typedef float f32x4 __attribute__((ext_vector_type(4)));
typedef short bf16x8 __attribute__((ext_vector_type(8)));
typedef GAS unsigned gu32;
typedef GAS unsigned long long gu64;
#define RLX_AGENT __ATOMIC_RELAXED, __HIP_MEMORY_SCOPE_AGENT
#define LDS_WAIT() asm volatile("s_waitcnt lgkmcnt(0)" ::: "memory")
#define VM_WAIT() asm volatile("s_waitcnt vmcnt(0)" ::: "memory")
__device__ __forceinline__ unsigned long long rt() { return __builtin_amdgcn_s_memrealtime(); }
__device__ __forceinline__ unsigned f2bf(float f) { unsigned u = __builtin_bit_cast(unsigned, f); return (u + 0x7fffu + ((u >> 16) & 1u)) >> 16; }
__device__ __forceinline__ unsigned pk2(float lo, float hi) { return f2bf(lo) | (f2bf(hi) << 16); }

#define XB_TMO      128
#define XB_XCNT(j)  (256  + 64 * (j))
#define XB_XSUB(j)  (1280 + 64 * (j))
#define XB_XGEN(j)  (2304 + 64 * (j))
#define XB_TOP      3328
#define XB_TOPGEN   3392
#define XCD_BAR_WORDS 3456
#define XB_SPIN_CAP (1u << 18)

__device__ __forceinline__ unsigned xb_ld(unsigned* p)              { return __hip_atomic_load(p, __ATOMIC_RELAXED, __HIP_MEMORY_SCOPE_AGENT); }
__device__ __forceinline__ unsigned xb_add(unsigned* p, unsigned v) { return __hip_atomic_fetch_add(p, v, __ATOMIC_RELAXED, __HIP_MEMORY_SCOPE_AGENT); }
__device__ __forceinline__ unsigned xb_xcc_id() { return (unsigned)__builtin_amdgcn_s_getreg((3 << 11) | 20) & 0xFu; }
#define XB_SPIN(cond, bar) do { unsigned _sp = 0; while (cond) { __builtin_amdgcn_s_sleep(1); \
    if ((++_sp & 255u) == 0u) { if (xb_ld(&(bar)[XB_TMO])) break; if (_sp > XB_SPIN_CAP) { atomicAdd(&(bar)[XB_TMO], 1u); break; } } } } while (0)

struct XcdBarrier {
    unsigned* bar; unsigned x;
    volatile LAS unsigned* st;
};

__device__ __forceinline__ XcdBarrier xcd_barrier_post(unsigned* bar, volatile LAS unsigned* st) {
    XcdBarrier b; b.bar = bar; b.x = xb_xcc_id(); b.st = st;
    if (threadIdx.x == 0) (void)xb_add(&bar[XB_XCNT(b.x)], 1u);
    return b;
}
__device__ __forceinline__ void xcd_barrier_complete(unsigned* bar, unsigned x, unsigned& nloc, unsigned& nx) {
    const unsigned G = gridDim.x * gridDim.y * gridDim.z;
    unsigned sum, cnt, mine, sp = 0u;
    for (;;) {
        sum = 0u; cnt = 0u; mine = 0u;
#pragma unroll
        for (unsigned j = 0; j < 16; ++j) { const unsigned c = xb_ld(&bar[XB_XCNT(j)]); sum += c; cnt += (c > 0u) ? 1u : 0u; mine = (j == x) ? c : mine; }
        if (sum == G) break;
        __builtin_amdgcn_s_sleep(1);
        if ((++sp & 255u) == 0u) { if (xb_ld(&bar[XB_TMO])) break; if (sp > XB_SPIN_CAP) { atomicAdd(&bar[XB_TMO], 1u); break; } }
    }
    nloc = mine > 0u ? mine : 1u; nx = cnt > 0u ? cnt : 1u;
}

__device__ __forceinline__ void xcd_barrier(const XcdBarrier& b) {
    asm volatile("s_waitcnt vmcnt(0)" ::: "memory");
    __syncthreads();
    if (threadIdx.x == 0) {
        unsigned* bar = b.bar;
        __builtin_amdgcn_s_waitcnt(0);
        unsigned nloc = b.st[0], nx = b.st[1];
        if (nloc == 0u) { xcd_barrier_complete(bar, b.x, nloc, nx); b.st[0] = nloc; b.st[1] = nx; }
        const unsigned old = xb_add(&bar[XB_XSUB(b.x)], 1u);
        const unsigned gen = old / nloc;
        if (old + 1u == (gen + 1u) * nloc) {
            __builtin_amdgcn_fence(__ATOMIC_RELEASE, "agent");
            asm volatile("s_waitcnt vmcnt(0)" ::: "memory");
            const unsigned og = xb_add(&bar[XB_TOP], 1u);
            const unsigned tg = og / nx;
            if (og + 1u == (tg + 1u) * nx) xb_add(&bar[XB_TOPGEN], 1u);
            else XB_SPIN(xb_ld(&bar[XB_TOPGEN]) == tg, bar);
            __builtin_amdgcn_fence(__ATOMIC_ACQUIRE, "agent");
            xb_add(&bar[XB_XGEN(b.x)], 1u);
            asm volatile("s_waitcnt vmcnt(0)" ::: "memory");
        } else {
            XB_SPIN(xb_ld(&bar[XB_XGEN(b.x)]) == gen, bar);
            __builtin_amdgcn_fence(__ATOMIC_ACQUIRE, "agent");
            asm volatile("s_waitcnt vmcnt(0)" ::: "memory");
        }
    }
    __syncthreads();
}
constexpr int NWAVES = 8;
constexpr int DM = 4096, DFF = 11008, NUP = 2 * DFF, NI = 12544;
constexpr int MREAL = 16384, MTOK = 16480, MP = 16640;
constexpr int NITEM = 2096;
constexpr int NCSEQ = 262;
constexpr float EPS = 1e-6f;
constexpr size_t MiB = 1u << 20;
constexpr size_t WS_CTL = 0, CTL_ZERO_BYTES = 65536;
constexpr size_t WS_AD = 1 * MiB;
constexpr size_t WS_X1M = 4 * MiB;
constexpr size_t WS_WD = 6 * MiB;
constexpr size_t WS_WI = 92 * MiB;
constexpr size_t WS_WO = 190 * MiB;
constexpr size_t WS_WU = 222 * MiB;
constexpr size_t WS_XQ = 308 * MiB;
constexpr size_t WS_CMAXP = 374 * MiB;
constexpr size_t WS_CS = 380 * MiB;
constexpr size_t WS_RFI = 381 * MiB;
constexpr int NI8T = 24, NI8C = NI8T * 256;
constexpr int CW_CMI = 8192;
constexpr size_t WS_XN = 394 * MiB;
constexpr size_t WS_PQK = 524 * MiB;
constexpr size_t WS_PC = 589 * MiB;
constexpr size_t WS_PV = 784 * MiB;
constexpr size_t WS_PR = 849 * MiB;
constexpr size_t WS_QT = 914 * MiB;
constexpr size_t WS_KT = 980 * MiB;
constexpr size_t WS_KH = 1046 * MiB;
constexpr size_t WS_ED = 1112 * MiB;
constexpr size_t WS_MIX = 1115 * MiB;
constexpr size_t WS_VT = 1245 * MiB;
constexpr size_t WS_END = 1335 * MiB;
constexpr size_t WS_O2 = WS_PQK;
constexpr size_t WS_H = WS_PQK;
constexpr size_t WS_EP = 870 * MiB, WS_EG = 876 * MiB, WS_EU = 882 * MiB;
constexpr size_t WS_EGM = 888 * MiB;
constexpr size_t WS_SSQ = 889 * MiB;
constexpr size_t WS_RSTD = 894 * MiB;
constexpr size_t WS_PART = 1311 * MiB;
static_assert(WS_H + (size_t)MREAL * DFF * 2 <= WS_EP && WS_EP + (size_t)64 * 2 * DFF * 4 <= WS_EG && WS_EGM + (size_t)6 * DFF * 4 <= WS_SSQ && WS_SSQ + (size_t)MP * 64 * 4 <= WS_RSTD && WS_RSTD + (size_t)MP * 4 <= WS_QT && WS_O2 + (size_t)2 * MP * 2048 * 2 <= WS_PV, "ws map");
static_assert(WS_QT + (size_t)2 * NITEM * 8192 * 2 <= WS_KT && WS_KH + (size_t)2 * NITEM * 8192 * 2 <= WS_ED && WS_ED + (size_t)2 * NITEM * 128 * 4 <= WS_MIX, "ws map 2");
constexpr int CW_BAR = 4096;
constexpr int CW_Q = 64;
constexpr int RING_BYTES = 131072, MISC_OFF = RING_BYTES + 320, LDS_BYTES = 147456;
constexpr int NPHASE = 12;
#ifndef MK_ONE_LAUNCH
#define MK_ONE_LAUNCH 1
#endif

typedef float f32x2v __attribute__((ext_vector_type(2)));
typedef unsigned u32x2v __attribute__((ext_vector_type(2)));

__device__ __forceinline__ float wave_sum(float v) {
#pragma unroll
    for (int o = 1; o < 64; o <<= 1) v += __shfl_xor(v, o);
    return v;
}
__device__ __forceinline__ float wave_max(float v) {
#pragma unroll
    for (int o = 1; o < 64; o <<= 1) v = fmaxf(v, __shfl_xor(v, o));
    return v;
}
__device__ __forceinline__ unsigned q8(float f) { return __builtin_bit_cast(unsigned, f + 12582912.0f) & 0xffu; }
__device__ __forceinline__ unsigned q8x4(float a, float b, float c, float d) { return q8(a) | (q8(b) << 8) | (q8(c) << 16) | (q8(d) << 24); }
__device__ __forceinline__ unsigned cvtpk(float lo, float hi) { return pg8::cvt_pk_bf16(lo, hi); }
__device__ __forceinline__ float bflo(unsigned w) { return __builtin_bit_cast(float, w << 16); }
__device__ __forceinline__ float bfhi(unsigned w) { return __builtin_bit_cast(float, w & 0xffff0000u); }
__device__ __forceinline__ float bf1(unsigned short h) { return __builtin_bit_cast(float, (unsigned)h << 16); }

__device__ __forceinline__ int seq_rowbase(int s) { return s < 2 ? s * 4096 : 8192 + (s - 2) * 2048; }
__device__ __forceinline__ int seq_len(int s) { return s < 2 ? 4096 : 2048; }
__device__ __forceinline__ int seq_nchunks(int s) { return s < 2 ? 65 : 33; }
__device__ __forceinline__ int seq_chunkbase(int s) { return s < 2 ? s * 65 : 130 + (s - 2) * 33; }
__device__ __forceinline__ void cs_decode(int cs, int& s, int& c) { if (cs < 130) { s = cs >= 65 ? 1 : 0; c = cs - s * 65; } else { const int j = cs - 130; s = 2 + j / 33; c = j - (s - 2) * 33; } }
__device__ __forceinline__ int chunk_row(int s, int c, int i) { return c == 0 ? (i < 48 ? -1 : 16384 + 16 * s + (i - 48)) : seq_rowbase(s) + 64 * (c - 1) + i; }
__device__ __forceinline__ int pos_row(int s, int p) { return p < 16 ? 16384 + 16 * s + p : seq_rowbase(s) + p - 16; }

struct CvDesc { const float* src; const float* ks; const float* cs; void* dst; int N, K, kind; };
#define WQ_HEAD 1.05f
#define WQC(x_) __builtin_amdgcn_fmed3f((x_), -127.0f, 127.0f)
struct CvRegs { f32x4 v[8]; float kv, cs; };
__device__ __forceinline__ void cv_load(const CvDesc& d, CvRegs& R, int lane) {
    const int kr = lane >> 3, nc4 = 4 * (lane & 7);
#pragma unroll
    for (int i = 0; i < 8; ++i) R.v[i] = __builtin_nontemporal_load((const GAS f32x4*)(d.src + (size_t)(kr + 8 * i) * d.N + nc4));
    R.kv = *(const GAS float*)(d.ks + lane);
    R.cs = *(const GAS float*)(d.cs + (lane & 31));
}
__device__ __forceinline__ void cv_finish(const CvDesc& d, CvRegs& R, LAS float* scr, int lane) {
    const int kr = lane >> 3, nc4 = 4 * (lane & 7);
#pragma unroll
    for (int i = 0; i < 8; ++i) { LAS float* p = scr + (kr + 8 * i) * 33 + nc4; p[0] = R.v[i].x; p[1] = R.v[i].y; p[2] = R.v[i].z; p[3] = R.v[i].w; }
    scr[64 * 33 + lane] = R.kv; if (lane < 32) scr[64 * 33 + 64 + lane] = R.cs;
    LDS_WAIT(); asm volatile("" ::: "memory");
    if (d.kind != 0) {
        const int c = lane & 3; const float cmul = d.kind == 2 ? (WQ_HEAD / 127.0f) : 1.0f;
        f32x4 kq[4];
#pragma unroll
        for (int i = 0; i < 4; ++i) { kq[i] = *(const LAS f32x4*)(scr + 64 * 33 + 16 * c + 4 * i); if (d.kind == 2) kq[i] = (f32x4){1.f, 1.f, 1.f, 1.f}; }
#pragma unroll
        for (int j = 0; j < 2; ++j) { const int n = (lane >> 2) + 16 * j; const LAS float* sp = scr + (16 * c) * 33 + n;
            const float cn = scr[64 * 33 + 64 + n] * cmul, inv = cn > 0.f ? __builtin_amdgcn_rcpf(cn) : 0.f;
            v4u o;
            o.x = q8x4(WQC(sp[0 * 33] * kq[0].x * inv), WQC(sp[1 * 33] * kq[0].y * inv), WQC(sp[2 * 33] * kq[0].z * inv), WQC(sp[3 * 33] * kq[0].w * inv));
            o.y = q8x4(WQC(sp[4 * 33] * kq[1].x * inv), WQC(sp[5 * 33] * kq[1].y * inv), WQC(sp[6 * 33] * kq[1].z * inv), WQC(sp[7 * 33] * kq[1].w * inv));
            o.z = q8x4(WQC(sp[8 * 33] * kq[2].x * inv), WQC(sp[9 * 33] * kq[2].y * inv), WQC(sp[10 * 33] * kq[2].z * inv), WQC(sp[11 * 33] * kq[2].w * inv));
            o.w = q8x4(WQC(sp[12 * 33] * kq[3].x * inv), WQC(sp[13 * 33] * kq[3].y * inv), WQC(sp[14 * 33] * kq[3].z * inv), WQC(sp[15 * 33] * kq[3].w * inv));
            *(GAS v4u*)((unsigned char*)d.dst + (size_t)n * d.K + 16 * c) = o; }
    } else {
        const int c = lane & 7;
#pragma unroll
        for (int j = 0; j < 4; ++j) { const int n = (lane >> 3) + 8 * j; const LAS float* sp = scr + (8 * c) * 33 + n;
            v4u o; o.x = cvtpk(sp[0 * 33], sp[1 * 33]); o.y = cvtpk(sp[2 * 33], sp[3 * 33]); o.z = cvtpk(sp[4 * 33], sp[5 * 33]); o.w = cvtpk(sp[6 * 33], sp[7 * 33]);
            *(GAS v4u*)((bf16*)d.dst + (size_t)n * d.K + 8 * c) = o; }
    }
    LDS_WAIT(); asm volatile("" ::: "memory");
}
constexpr int CV_NB_I = 12320 / 32, CV_I_I = (DM / 64) * CV_NB_I;
constexpr int CV_NB_O = DM / 32, CV_NB_U = NUP / 32, CV_NB_D = DM / 32, CV_I_O = (DM / 64) * CV_NB_O, CV_I_U = (DM / 64) * CV_NB_U, CV_I_D = (DFF / 64) * CV_NB_D, CV_I_REST = CV_I_O + CV_I_U + CV_I_D;
__device__ __forceinline__ int in_src_col(int n0) {
    if (n0 < 4096) return n0 + 2048; if (n0 < 6144) return n0 - 4096; if (n0 < 8192) return n0 + 32; if (n0 >= 12288) return 6144;
    const int o = n0 - 8192; return ((o & 128) ? 10272 : 8224) + 128 * (o >> 8) + (o & 127);
}
__device__ __forceinline__ CvDesc cv_desc_in(int it, const float* w_in, const float* dummy, const float* CMI, bf16* WI) {
    const int kb = it / CV_NB_I, nb = it - kb * CV_NB_I, n0 = 32 * nb;
    CvDesc d; d.src = w_in + (size_t)(64 * kb) * 12320 + in_src_col(n0); d.ks = dummy; d.N = 12320;
    if (n0 < NI8C) { d.cs = CMI + n0; d.dst = (unsigned char*)WI + (size_t)n0 * DM + 64 * kb; d.K = DM; d.kind = 2; }
    else { d.cs = dummy; d.dst = WI + (size_t)n0 * DM + 64 * kb; d.K = DM; d.kind = 0; }
    return d;
}
__device__ __forceinline__ CvDesc cv_desc_rest(int it, const float* w_out, const float* w_up, const float* w_down, const float* ffn_g, const float* CS, bf16* WO, unsigned char* WU, bf16* WD) {
    CvDesc d; int r = it;
    if (r < CV_I_O) { const int kb = r / CV_NB_O, nb = r - kb * CV_NB_O; d.src = w_out + (size_t)(64 * kb) * DM + 32 * nb; d.ks = ffn_g; d.cs = ffn_g; d.dst = WO + (size_t)(32 * nb) * DM + 64 * kb; d.N = DM; d.K = DM; d.kind = 0; return d; }
    r -= CV_I_O;
    if (r < CV_I_U) { const int kb = r / CV_NB_U, nb = r - kb * CV_NB_U, pn = nb >> 3, j = nb & 7;
        const int srcn = j < 4 ? 128 * pn + 32 * j : DFF + 128 * pn + 32 * (j - 4);
        d.src = w_up + (size_t)(64 * kb) * NUP + srcn; d.ks = ffn_g + 64 * kb; d.cs = CS + srcn; d.dst = WU + (size_t)(32 * nb) * DM + 64 * kb; d.N = NUP; d.K = DM; d.kind = 1; return d; }
    r -= CV_I_U;
    { const int kb = r / CV_NB_D, nb = r - kb * CV_NB_D; d.src = w_down + (size_t)(64 * kb) * DM + 32 * nb; d.ks = ffn_g; d.cs = ffn_g; d.dst = WD + (size_t)(32 * nb) * DFF + 64 * kb; d.N = DM; d.K = DFF; d.kind = 0; return d; }
}
__device__ __forceinline__ void norm_row_q(const float* xrow, const float* g, bf16* orow, unsigned char* qrow, float* rf, int lane) {
    f32x4 v[16]; float s = 0.f;
#pragma unroll
    for (int j = 0; j < 8; ++j) { const GAS f32x4* p = (const GAS f32x4*)(xrow + 8 * lane + 512 * j); v[2 * j] = p[0]; v[2 * j + 1] = p[1]; }
#pragma unroll
    for (int j = 0; j < 16; ++j) s += (v[j].x * v[j].x + v[j].y * v[j].y) + (v[j].z * v[j].z + v[j].w * v[j].w);
    const float rstd = 1.0f / sqrtf(wave_sum(s) * (1.0f / 4096.0f) + EPS);
    float amax = 0.f;
#pragma unroll
    for (int j = 0; j < 8; ++j) { const GAS f32x4* gp = (const GAS f32x4*)(g + 8 * lane + 512 * j); const f32x4 a = v[2 * j] * rstd * gp[0], b = v[2 * j + 1] * rstd * gp[1]; v[2 * j] = a; v[2 * j + 1] = b;
        amax = fmaxf(amax, fmaxf(fmaxf(fmaxf(fabsf(a.x), fabsf(a.y)), fmaxf(fabsf(a.z), fabsf(a.w))), fmaxf(fmaxf(fabsf(b.x), fabsf(b.y)), fmaxf(fabsf(b.z), fabsf(b.w)))));
        v4u o; o.x = cvtpk(a.x, a.y); o.y = cvtpk(a.z, a.w); o.z = cvtpk(b.x, b.y); o.w = cvtpk(b.z, b.w); *(GAS v4u*)(orow + 8 * lane + 512 * j) = o; }
    amax = wave_max(amax); const float sc = amax > 0.f ? 127.0f / amax : 0.f;
#pragma unroll
    for (int j = 0; j < 8; ++j) { const f32x4 a = v[2 * j] * sc, b = v[2 * j + 1] * sc; u32x2v o; o.x = q8x4(a.x, a.y, a.z, a.w); o.y = q8x4(b.x, b.y, b.z, b.w); *(GAS u32x2v*)(qrow + 8 * lane + 512 * j) = o; }
    if (lane == 0) *rf = amax * (1.0f / 127.0f);
}

__device__ __forceinline__ float fexp(float x) { return __builtin_amdgcn_exp2f(x * 1.4426950408889634f); }
__device__ __forceinline__ float logsig16(float x) { return (fminf(x, 0.f) - __builtin_amdgcn_logf(1.0f + fexp(-fabsf(x))) * 0.6931471805599453f) * 0.0625f; }
template <int PVAR> __device__ __forceinline__ void prep_item(int it, LAS unsigned char* lds, const float* AD, const bf16* PQK, const bf16* PV, const float* wg2, const float* bg2, bf16* QT, bf16* KT, bf16* KH, float* ED, bf16* VT, int tid, int wave, int lane) {
    const int cs = it >> 3, h = it & 7; int s, c; cs_decode(cs, s, c);
    asm volatile("" : "+v"(tid)); lane = tid & 63;
    LAS float* sA = (LAS float*)lds;
    LAS float* sT = (LAS float*)(lds + 8192);
    const int dp = lane, tg = wave, fr = lane & 15, fq = lane >> 4, tb = wave >> 1;
    const int rowa = chunk_row(s, c, tid >> 3), rowv = chunk_row(s, c, 16 * tb + fr);
    f32x4 a4 = *(const GAS f32x4*)(AD + (size_t)(rowa >= 0 ? rowa : 0) * 32 + (tid & 7) * 4);
    unsigned qw[8], kw[8];
#pragma unroll
    for (int j = 0; j < 8; ++j) { const int row = chunk_row(s, c, 8 * tg + j); const size_t ro = (size_t)(row >= 0 ? row : 0) * 2048 + h * 128 + 2 * dp;
        qw[j] = *(const GAS unsigned*)(PQK + ro); kw[j] = *(const GAS unsigned*)(PQK + ro + 1024); if (row < 0) { qw[j] = 0u; kw[j] = 0u; } }
    v4u va[4];
#pragma unroll
    for (int kbi = 0; kbi < 4; ++kbi) { va[kbi] = *(const GAS v4u*)(PV + (size_t)(rowv >= 0 ? rowv : 0) * 2048 + h * 256 + 32 * ((wave & 1) * 4 + kbi) + 8 * fq); if (rowv < 0) va[kbi] = (v4u){0u, 0u, 0u, 0u}; }
    if (rowa < 0) a4 = (f32x4){0.f, 0.f, 0.f, 0.f};
    *(LAS f32x4*)(sA + (tid >> 3) * 32 + (tid & 7) * 4) = a4;
    __syncthreads();
    f32x2v lf[8], lb[8];
#pragma unroll
    for (int zz = 0; zz < 2; ++zz) {
        f32x2v w[16];
#pragma unroll
        for (int i = 0; i < 16; ++i) w[i] = *(const GAS f32x2v*)(wg2 + zz * 16384 + (size_t)i * 1024 + h * 128 + 2 * dp);
        const f32x2v bw = *(const GAS f32x2v*)(bg2 + zz * 1024 + h * 128 + 2 * dp);
#pragma unroll
        for (int j = 0; j < 8; ++j) { const int i = 8 * tg + j; const bool padtok = (c == 0 && i < 48);
            f32x2v x = bw;
#pragma unroll
            for (int k4 = 0; k4 < 4; ++k4) { const f32x4 a = *(const LAS f32x4*)(sA + i * 32 + 16 * zz + 4 * k4);
                x += w[4 * k4] * a.x + w[4 * k4 + 1] * a.y + w[4 * k4 + 2] * a.z + w[4 * k4 + 3] * a.w; }
            const f32x2v l = (f32x2v){padtok ? 0.f : logsig16(x.x), padtok ? 0.f : logsig16(x.y)};
            if (zz == 0) lf[j] = l; else lb[j] = l; }
    }
#pragma unroll
    for (int j = 1; j < 8; ++j) lf[j] += lf[j - 1];
#pragma unroll
    for (int j = 6; j >= 0; --j) lb[j] += lb[j + 1];
    *(LAS f32x2v*)(sT + tg * 128 + 2 * dp) = lf[7];
    *(LAS f32x2v*)(sT + 1024 + tg * 128 + 2 * dp) = lb[0];
    __syncthreads();
    f32x2v offf = (f32x2v){0.f, 0.f}, offb = offf, allf = offf, allb = offf;
#pragma unroll
    for (int g = 0; g < 8; ++g) { const f32x2v tf = *(const LAS f32x2v*)(sT + g * 128 + 2 * dp), tb2 = *(const LAS f32x2v*)(sT + 1024 + g * 128 + 2 * dp);
        allf += tf; allb += tb2; if (g < tg) offf += tf; if (g > tg) offb += tb2; }
    const size_t ib = (size_t)it * 8192, zb = (size_t)NITEM * 8192;
    bf16 *QTf = QT + ib, *QTb = QT + zb + ib, *KTf = KT + ib, *KTb = KT + zb + ib, *KHf = KH + ib, *KHb = KH + zb + ib;
    const float qs = 0.08838834764831845f;
    const f32x2v eaf = (f32x2v){fexp(allf.x), fexp(allf.y)}, eab = (f32x2v){fexp(allb.x), fexp(allb.y)};
    unsigned khf0[4], khf1[4], khb0[4], khb1[4];
    float pf0 = 0.f, pf1 = 0.f, pb0 = 0.f, pb1 = 0.f;
#pragma unroll
    for (int j = 0; j < 8; ++j) { const int i = 8 * tg + j;
        const float q0 = bflo(qw[j]) * qs, q1 = bfhi(qw[j]) * qs, k0 = bflo(kw[j]), k1 = bfhi(kw[j]);
        const f32x2v Bp = offf + lf[j], Bs = offb + lb[j];
        const float ef0 = fexp(Bp.x), ef1 = fexp(Bp.y), eb0 = fexp(Bs.x), eb1 = fexp(Bs.y);
        const float rf0 = __builtin_amdgcn_rcpf(ef0), rf1 = __builtin_amdgcn_rcpf(ef1), rb0 = __builtin_amdgcn_rcpf(eb0), rb1 = __builtin_amdgcn_rcpf(eb1);
        if (PVAR != 1) { *(GAS unsigned*)(QTf + i * 128 + 2 * dp) = cvtpk(q0 * ef0, q1 * ef1);
        *(GAS unsigned*)(QTb + i * 128 + 2 * dp) = cvtpk(q0 * eb0, q1 * eb1); } else { asm volatile("" :: "v"(q0 * ef0), "v"(q1 * ef1), "v"(q0 * eb0), "v"(q1 * eb1)); }
        const float ktf0 = k0 * rf0, ktf1 = k1 * rf1, ktb0 = k0 * rb0, ktb1 = k1 * rb1;
        if (PVAR != 1) { *(GAS unsigned*)(KTf + i * 128 + 2 * dp) = cvtpk(ktf0, ktf1);
        *(GAS unsigned*)(KTb + i * 128 + 2 * dp) = cvtpk(ktb0, ktb1); }
        const float hf0 = ktf0 * eaf.x, hf1 = ktf1 * eaf.y, hb0 = ktb0 * eab.x, hb1 = ktb1 * eab.y;
        if (j & 1) { khf0[j >> 1] = cvtpk(pf0, hf0); khf1[j >> 1] = cvtpk(pf1, hf1); khb0[j >> 1] = cvtpk(pb0, hb0); khb1[j >> 1] = cvtpk(pb1, hb1); }
        else { pf0 = hf0; pf1 = hf1; pb0 = hb0; pb1 = hb1; } }
    LAS unsigned char* sKf = lds + 16384; LAS unsigned char* sKb = lds + 34816; LAS unsigned char* sV = lds + 53248;
    *(LAS v4u*)(sKf + (2 * dp) * 144 + 16 * tg) = (v4u){khf0[0], khf0[1], khf0[2], khf0[3]};
    *(LAS v4u*)(sKf + (2 * dp + 1) * 144 + 16 * tg) = (v4u){khf1[0], khf1[1], khf1[2], khf1[3]};
    *(LAS v4u*)(sKb + (2 * dp) * 144 + 16 * tg) = (v4u){khb0[0], khb0[1], khb0[2], khb0[3]};
    *(LAS v4u*)(sKb + (2 * dp + 1) * 144 + 16 * tg) = (v4u){khb1[0], khb1[1], khb1[2], khb1[3]};
    if (tg == 0) { *(GAS f32x2v*)(ED + (size_t)it * 128 + 2 * dp) = eaf;
                   *(GAS f32x2v*)(ED + (size_t)(NITEM + it) * 128 + 2 * dp) = eab; }
    { short e0[8], e1[8];
#pragma unroll
      for (int j = 0; j < 8; ++j) { e0[j] = (8 * fq + j == fr) ? (short)0x3F80 : (short)0; e1[j] = (8 * fq + j == fr + 16) ? (short)0x3F80 : (short)0; }
      const bf16x8 sel0 = (bf16x8){e0[0], e0[1], e0[2], e0[3], e0[4], e0[5], e0[6], e0[7]}, sel1 = (bf16x8){e1[0], e1[1], e1[2], e1[3], e1[4], e1[5], e1[6], e1[7]};
      bf16* vt = VT + (size_t)it * 16384;
#pragma unroll
      for (int kbi = 0; kbi < 4; ++kbi) { const int kb = (wave & 1) * 4 + kbi;
          const bf16x8 A = __builtin_bit_cast(bf16x8, va[kbi]);
          const f32x4 d0 = __builtin_amdgcn_mfma_f32_16x16x32_bf16(A, sel0, (f32x4){0.f, 0.f, 0.f, 0.f}, 0, 0, 0), d1 = __builtin_amdgcn_mfma_f32_16x16x32_bf16(A, sel1, (f32x4){0.f, 0.f, 0.f, 0.f}, 0, 0, 0);
          *(LAS u32x2v*)(sV + (32 * kb + fr) * 144 + (16 * tb + 4 * fq) * 2) = (u32x2v){cvtpk(d0[0], d0[1]), cvtpk(d0[2], d0[3])};
          *(LAS u32x2v*)(sV + (32 * kb + 16 + fr) * 144 + (16 * tb + 4 * fq) * 2) = (u32x2v){cvtpk(d1[0], d1[1]), cvtpk(d1[2], d1[3])}; }
      __syncthreads();
#pragma unroll
      for (int i = 0; i < 2; ++i) { const int q = tid + 512 * i, o = (q >> 3) * 144 + (q & 7) * 16;
          ((GAS v4u*)KHf)[q] = *(const LAS v4u*)(sKf + o); ((GAS v4u*)KHb)[q] = *(const LAS v4u*)(sKb + o); }
#pragma unroll
      for (int i = 0; i < 4; ++i) { const int q = tid + 512 * i; ((GAS v4u*)vt)[q] = *(const LAS v4u*)(sV + (q >> 3) * 144 + (q & 7) * 16); } }
}
__device__ __forceinline__ void load_m8(const bf16* PC, int row, int ch0, float (&m)[8]) {
    const v4u a = *(const GAS v4u*)(PC + (size_t)row * 4096 + 2048 + ch0);
    m[0] = bflo(a.x); m[1] = bfhi(a.x); m[2] = bflo(a.y); m[3] = bfhi(a.y); m[4] = bflo(a.z); m[5] = bfhi(a.z); m[6] = bflo(a.w); m[7] = bfhi(a.w);
}
constexpr int NCONV = 2 * 257 + 4 * 129;
__device__ __forceinline__ void conv_item(int ci, const bf16* PC, const float* cw, bf16* MIX, int tid) {
    asm volatile("" : "+v"(tid));
    int s, blk; if (ci < 514) { s = ci >= 257 ? 1 : 0; blk = ci - s * 257; } else { const int j = ci - 514; s = 2 + j / 129; blk = j - (s - 2) * 129; }
    const int np = seq_len(s) + 16, ch0 = 8 * (tid & 255), p0 = 16 * blk + 8 * (tid >> 8);
    float m[10][8]; v4u cbw[8];
#pragma unroll
    for (int j = 0; j < 10; ++j) { const int p = p0 - 1 + j;
        if (p >= 0 && p < np) load_m8(PC, pos_row(s, p), ch0, m[j]);
        else {
#pragma unroll
            for (int e = 0; e < 8; ++e) m[j][e] = 0.f; } }
#pragma unroll
    for (int j = 0; j < 8; ++j) cbw[j] = *(const GAS v4u*)(PC + (size_t)pos_row(s, p0 + j) * 4096 + ch0);
    float w0[8], w1[8], w2[8];
#pragma unroll
    for (int e = 0; e < 8; ++e) { w0[e] = cw[ch0 + e]; w1[e] = cw[2048 + ch0 + e]; w2[e] = cw[4096 + ch0 + e]; }
#pragma unroll
    for (int j = 0; j < 8; ++j) { const v4u c4 = cbw[j];
        const float cbv[8] = {bflo(c4.x), bfhi(c4.x), bflo(c4.y), bfhi(c4.y), bflo(c4.z), bfhi(c4.z), bflo(c4.w), bfhi(c4.w)};
        float o[8];
#pragma unroll
        for (int e = 0; e < 8; ++e) o[e] = cbv[e] * (w0[e] * m[j][e] + w1[e] * m[j + 1][e] + w2[e] * m[j + 2][e]);
        v4u ow; ow.x = cvtpk(o[0], o[1]); ow.y = cvtpk(o[2], o[3]); ow.z = cvtpk(o[4], o[5]); ow.w = cvtpk(o[6], o[7]);
        *(GAS v4u*)(MIX + (size_t)pos_row(s, p0 + j) * 4096 + 2048 + ch0) = ow; }
}

#ifndef SCAN_DIST
#define SCAN_DIST 2
#endif
constexpr int SC_BUF = 51712, SC_KT = 16384, SC_KH = 32768, SC_ED = 51200, SC_P = 2 * SC_BUF;
__device__ __forceinline__ bf16x8 mk8(unsigned a, unsigned b, unsigned c, unsigned d) { const v4u t = (v4u){a, b, c, d}; return __builtin_bit_cast(bf16x8, t); }
struct ScanRegs { v4u q[2], k[2], h[2], v[2]; f32x4 ed; };
template <int SVAR> __device__ __forceinline__ void scan_item(int idx, LAS unsigned char* lds, const bf16* QT, const bf16* KT, const bf16* KH, const float* ED, const bf16* VT, bf16* O2, int tid, int wave, int lane) {
    int s, rem; if (idx < 64) { s = idx >> 5; rem = idx & 31; } else { s = 2 + ((idx - 64) >> 5); rem = (idx - 64) & 31; }
    const int h = rem >> 2, z = (rem >> 1) & 1, vh = rem & 1;
    const int nc = seq_nchunks(s), cbase = seq_chunkbase(s);
    const int fr = lane & 15, fq = lane >> 4;
    const int vrow = vh * 128 + 16 * wave + fr;
    const int ocol = h * 256 + vh * 128 + 16 * wave + 4 * fq;
    f32x4 Sacc[8];
#pragma unroll
    for (int i = 0; i < 8; ++i) Sacc[i] = (f32x4){0.f, 0.f, 0.f, 0.f};
    ScanRegs RA, RB; bf16x8 vcur[2];
    RA.ed = (f32x4){0.f, 0.f, 0.f, 0.f}; RB.ed = RA.ed;
#define SC_CH(st_) (z ? nc - 1 - (st_) : (st_))
#define SC_LOAD(R_, c_) do { const int it_ = (cbase + (c_)) * 8 + h; const size_t ib_ = ((size_t)z * NITEM + it_) * 8192; \
        _Pragma("unroll") for (int i_ = 0; i_ < 2; ++i_) { R_.q[i_] = ((const GAS v4u*)(QT + ib_))[tid + 512 * i_]; R_.k[i_] = ((const GAS v4u*)(KT + ib_))[tid + 512 * i_]; R_.h[i_] = ((const GAS v4u*)(KH + ib_))[tid + 512 * i_]; \
            R_.v[i_] = *(const GAS v4u*)(VT + (size_t)it_ * 16384 + (size_t)vrow * 64 + 32 * i_ + 8 * fq); } \
        R_.ed = ((const GAS f32x4*)(ED + ((size_t)z * NITEM + it_) * 128))[tid & 31]; } while (0)
#define SC_WRITE(R_, b_) do { LAS unsigned char* bb_ = lds + (b_) * SC_BUF; \
        _Pragma("unroll") for (int i_ = 0; i_ < 2; ++i_) { const int q_ = tid + 512 * i_; const int r_ = q_ >> 4, c_ = q_ & 15; const int o_ = r_ * 256 + ((c_ ^ (r_ & 15)) << 4); \
            *(LAS v4u*)(bb_ + o_) = R_.q[i_]; *(LAS v4u*)(bb_ + SC_KT + o_) = R_.k[i_]; *(LAS v4u*)(bb_ + SC_KH + (q_ >> 3) * 144 + (q_ & 7) * 16) = R_.h[i_]; } \
        if (tid < 32) *(LAS f32x4*)(bb_ + SC_ED + tid * 16) = R_.ed; \
        vcur[0] = __builtin_bit_cast(bf16x8, R_.v[0]); vcur[1] = __builtin_bit_cast(bf16x8, R_.v[1]); } while (0)
#define SC_STEP(step_, b_, RL_, RW_, DIST_, LAST_) do { const int c = SC_CH(step_); \
        LAS unsigned char* QTb = lds + (b_) * SC_BUF; LAS unsigned char* KTb = QTb + SC_KT; LAS unsigned char* KHb = QTb + SC_KH; LAS unsigned char* EDb = QTb + SC_ED; LAS unsigned char* Pb = lds + SC_P; \
        if (!(LAST_) && SVAR != 1) { const int sl_ = (step_) + (DIST_) < nc ? (step_) + (DIST_) : nc - 1; SC_LOAD(RL_, SC_CH(sl_)); }     \
          \
        _Pragma("unroll") for (int e2 = 0; e2 < 2; ++e2) { const int e = 2 * wave + e2, si = e >> 2, ti = e & 3; \
            f32x4 a4 = (f32x4){0.f, 0.f, 0.f, 0.f}; \
            _Pragma("unroll") for (int kk = 0; kk < 4; ++kk) { const int off = (((4 * kk + fq) ^ fr) << 4); \
                const bf16x8 A = *(const LAS bf16x8*)(KTb + (16 * si + fr) * 256 + off), B = *(const LAS bf16x8*)(QTb + (16 * ti + fr) * 256 + off); \
                a4 = __builtin_amdgcn_mfma_f32_16x16x32_bf16(A, B, a4, 0, 0, 0); } \
            const int tg_ = 16 * ti + fr, sg0 = 16 * si + 4 * fq; float p[4]; \
            _Pragma("unroll") for (int r = 0; r < 4; ++r) { const int sg = sg0 + r; const bool keep = z ? (sg > tg_) : (sg <= tg_); p[r] = keep ? a4[r] : 0.f; } \
            *(LAS u32x2v*)(Pb + tg_ * 144 + sg0 * 2) = (u32x2v){cvtpk(p[0], p[1]), cvtpk(p[2], p[3])}; } \
          \
        f32x4 oacc[4]; \
        _Pragma("unroll") for (int ti = 0; ti < 4; ++ti) oacc[ti] = (f32x4){0.f, 0.f, 0.f, 0.f}; \
        _Pragma("unroll") for (int kk = 0; kk < 4; ++kk) { \
            const bf16x8 Sb = mk8(cvtpk(Sacc[2 * kk][0], Sacc[2 * kk][1]), cvtpk(Sacc[2 * kk][2], Sacc[2 * kk][3]), cvtpk(Sacc[2 * kk + 1][0], Sacc[2 * kk + 1][1]), cvtpk(Sacc[2 * kk + 1][2], Sacc[2 * kk + 1][3])); \
            _Pragma("unroll") for (int ti = 0; ti < 4; ++ti) { const LAS unsigned char* rp = QTb + (16 * ti + fr) * 256 + (fq & 1) * 8; \
                const u32x2v lo = *(const LAS u32x2v*)(rp + (((4 * kk + (fq >> 1)) ^ fr) << 4)), hi = *(const LAS u32x2v*)(rp + (((4 * kk + 2 + (fq >> 1)) ^ fr) << 4)); \
                oacc[ti] = __builtin_amdgcn_mfma_f32_16x16x32_bf16(Sb, mk8(lo.x, lo.y, hi.x, hi.y), oacc[ti], 0, 0, 0); } } \
        __syncthreads();                                \
          \
        _Pragma("unroll") for (int ti = 0; ti < 4; ++ti) \
            _Pragma("unroll") for (int kk = 0; kk < 2; ++kk) { const bf16x8 Bp = *(const LAS bf16x8*)(Pb + (16 * ti + fr) * 144 + (32 * kk + 8 * fq) * 2); \
                oacc[ti] = __builtin_amdgcn_mfma_f32_16x16x32_bf16(vcur[kk], Bp, oacc[ti], 0, 0, 0); } \
          \
        _Pragma("unroll") for (int ti = 0; ti < 4; ++ti) { int row = chunk_row(s, c, 16 * ti + fr); row = row >= 0 ? row : MP - 1;     \
            if (SVAR == 0) *(GAS u32x2v*)(O2 + ((size_t)z * MP + row) * 2048 + ocol) = (u32x2v){cvtpk(oacc[ti][0], oacc[ti][1]), cvtpk(oacc[ti][2], oacc[ti][3])}; else asm volatile("" :: "v"(oacc[ti])); } \
          \
        _Pragma("unroll") for (int i8 = 0; i8 < 8; ++i8) { const f32x4 ed4 = *(const LAS f32x4*)(EDb + (16 * i8 + 4 * fq) * 4); Sacc[i8] = Sacc[i8] * ed4; \
            _Pragma("unroll") for (int kk = 0; kk < 2; ++kk) { const bf16x8 A = *(const LAS bf16x8*)(KHb + (16 * i8 + fr) * 144 + (32 * kk + 8 * fq) * 2); \
                Sacc[i8] = __builtin_amdgcn_mfma_f32_16x16x32_bf16(A, vcur[kk], Sacc[i8], 0, 0, 0); } } \
        if (!(LAST_) && SVAR != 1) SC_WRITE(RW_, (b_) ^ 1); \
        __syncthreads(); } while (0)
    SC_LOAD(RA, SC_CH(0)); SC_WRITE(RA, 0);
#if SCAN_DIST == 2
    SC_LOAD(RB, SC_CH(1));
    __syncthreads();
    for (int step = 0; step + 1 < nc; step += 2) {
        SC_STEP(step, 0, RA, RB, 2, false);
        SC_STEP(step + 1, 1, RB, RA, 2, false);
    }
    SC_STEP(nc - 1, 0, RA, RB, 2, true);
#else
    __syncthreads();
    for (int step = 0; step + 1 < nc; step += 2) {
        SC_STEP(step, 0, RA, RA, 1, false);
        SC_STEP(step + 1, 1, RA, RA, 1, false);
    }
    SC_STEP(nc - 1, 0, RA, RA, 1, true);
#endif
#undef SC_CH
#undef SC_LOAD
#undef SC_WRITE
#undef SC_STEP
}

__device__ __forceinline__ void fixup_item(int q, const float* EP, const float* EG, const float* EU, const float* EGM, const float* fw, bf16* H) {
    const int er = q / 1376, cg = q - er * 1376, pm = er >> 1, e = er & 1, f0 = 8 * cg;
    const int s = pm < 32 ? (pm >> 4) : 2 + ((pm - 32) >> 3);
    const bool first = pm < 32 ? ((pm & 15) == 0) : (((pm - 32) & 7) == 0), last = pm < 32 ? ((pm & 15) == 15) : (((pm - 32) & 7) == 7);
    const size_t eo = ((size_t)pm * 2 + e) * DFF + f0;
    f32x4 nb0 = (f32x4){0.f, 0.f, 0.f, 0.f}, nb1 = nb0, wv0, wv1;
    if (e == 0) { const float* gsrc = first ? EGM + (size_t)s * DFF + f0 : EG + ((size_t)(pm - 1) * 2 + 1) * DFF + f0; nb0 = *(const GAS f32x4*)gsrc; nb1 = *(const GAS f32x4*)(gsrc + 4);
                  wv0 = *(const GAS f32x4*)(fw + f0); wv1 = *(const GAS f32x4*)(fw + f0 + 4); }
    else { if (!last) { const float* gsrc = EG + ((size_t)(pm + 1) * 2) * DFF + f0; nb0 = *(const GAS f32x4*)gsrc; nb1 = *(const GAS f32x4*)(gsrc + 4); }
           wv0 = *(const GAS f32x4*)(fw + 2 * DFF + f0); wv1 = *(const GAS f32x4*)(fw + 2 * DFF + f0 + 4); }
    const f32x4 p0 = *(const GAS f32x4*)(EP + eo) + wv0 * nb0, p1 = *(const GAS f32x4*)(EP + eo + 4) + wv1 * nb1;
    const f32x4 u0 = *(const GAS f32x4*)(EU + eo), u1 = *(const GAS f32x4*)(EU + eo + 4);
    float o[8];
#pragma unroll
    for (int j = 0; j < 4; ++j) { o[j] = p0[j] * __builtin_amdgcn_rcpf(1.0f + __builtin_amdgcn_exp2f(-1.4426950408889634f * p0[j])) * u0[j];
                                  o[4 + j] = p1[j] * __builtin_amdgcn_rcpf(1.0f + __builtin_amdgcn_exp2f(-1.4426950408889634f * p1[j])) * u1[j]; }
    v4u ow; ow.x = cvtpk(o[0], o[1]); ow.y = cvtpk(o[2], o[3]); ow.z = cvtpk(o[4], o[5]); ow.w = cvtpk(o[6], o[7]);
    *(GAS v4u*)(H + (size_t)(pm * 256 + (e ? 255 : 0)) * DFF + f0) = ow;
}

__device__ __forceinline__ f32x4 thin_tile(const bf16* arow, const bf16* brow, int fq) {
    f32x4 acc = (f32x4){0.f, 0.f, 0.f, 0.f};
    for (int kb = 0; kb < 8; ++kb) {
        v4u a[16], bb[16];
#pragma unroll
        for (int i = 0; i < 16; ++i) { a[i] = *(const GAS v4u*)(arow + kb * 512 + 32 * i + 8 * fq); bb[i] = *(const GAS v4u*)(brow + kb * 512 + 32 * i + 8 * fq); }
#pragma unroll
        for (int i = 0; i < 16; ++i) acc = __builtin_amdgcn_mfma_f32_16x16x32_bf16(__builtin_bit_cast(bf16x8, a[i]), __builtin_bit_cast(bf16x8, bb[i]), acc, 0, 0, 0);
    }
    return acc;
}

__device__ __forceinline__ pg8::i32x4 thin_tile_i8(const unsigned char* arow, const unsigned char* brow, int fq) {
    pg8::i32x4 acc = (pg8::i32x4){0, 0, 0, 0};
    for (int kb = 0; kb < 4; ++kb) {
        v4u a[16], bb[16];
#pragma unroll
        for (int i = 0; i < 16; ++i) { a[i] = *(const GAS v4u*)(arow + kb * 1024 + 64 * i + 16 * fq); bb[i] = *(const GAS v4u*)(brow + kb * 1024 + 64 * i + 16 * fq); }
#pragma unroll
        for (int i = 0; i < 16; ++i) acc = __builtin_amdgcn_mfma_i32_16x16x64_i8(__builtin_bit_cast(pg8::i32x4, a[i]), __builtin_bit_cast(pg8::i32x4, bb[i]), acc, 0, 0, 0);
    }
    return acc;
}

struct Args { const float* in[16]; float* out; unsigned char* ws; int ph_lo, ph_hi; };
__global__ void __launch_bounds__(NWAVES * 64, 2) fwd(Args args) {
    extern __shared__ __attribute__((aligned(16))) unsigned char lds_raw[];
    LAS unsigned char* lds = (LAS unsigned char*)lds_raw;
    volatile LAS unsigned* MISC = (volatile LAS unsigned*)(lds + MISC_OFF);
    const int tid = threadIdx.x, lane = tid & 63, wave = __builtin_amdgcn_readfirstlane(tid >> 6);
    const int G = gridDim.x, bid = blockIdx.x;
    const int gw = bid * NWAVES + wave, NGW = G * NWAVES;
    unsigned char* ws = args.ws;
    gu32* ctl = (gu32*)(ws + WS_CTL);
    const float *x_prompt = args.in[0], *x_sample = args.in[1], *meta = args.in[2], *mix_g = args.in[3], *w_in = args.in[4], *wg2 = args.in[5], *bg2 = args.in[6], *hng = args.in[7],
                *cmw = args.in[8], *w_out = args.in[9], *ffn_g = args.in[10], *w_up = args.in[11], *fcw = args.in[12], *fcb = args.in[13], *w_down = args.in[14], *fin_g = args.in[15];
    float* out = args.out;
    float* AD = (float*)(ws + WS_AD); float* X1M = (float*)(ws + WS_X1M);
    bf16 *WD = (bf16*)(ws + WS_WD), *WI = (bf16*)(ws + WS_WI), *WO = (bf16*)(ws + WS_WO), *XN = (bf16*)(ws + WS_XN);
    unsigned char *WU = ws + WS_WU, *XQ = ws + WS_XQ, *WI8 = ws + WS_WI; float *CMAXP = (float*)(ws + WS_CMAXP), *CS = (float*)(ws + WS_CS), *RFI = (float*)(ws + WS_RFI); float* CMI = (float*)(ctl + CW_CMI);
    bf16 *PQK = (bf16*)(ws + WS_PQK), *PC = (bf16*)(ws + WS_PC), *PV = (bf16*)(ws + WS_PV), *PR = (bf16*)(ws + WS_PR);
    bf16 *QT = (bf16*)(ws + WS_QT), *KT = (bf16*)(ws + WS_KT), *KH = (bf16*)(ws + WS_KH), *VT = (bf16*)(ws + WS_VT); float* ED = (float*)(ws + WS_ED);
    bf16 *MIX = (bf16*)(ws + WS_MIX), *O2 = (bf16*)(ws + WS_O2), *HB = (bf16*)(ws + WS_H);
    float* PART = (float*)(ws + WS_PART);
    float *EP = (float*)(ws + WS_EP), *EG = (float*)(ws + WS_EG), *EU = (float*)(ws + WS_EU), *EGM = (float*)(ws + WS_EGM), *SSQ = (float*)(ws + WS_SSQ), *RSTD = (float*)(ws + WS_RSTD);

    for (int u = tid; u < (LDS_BYTES - RING_BYTES) / 4; u += NWAVES * 64) ((LAS unsigned*)(lds + RING_BYTES))[u] = 0u;
    __syncthreads();
    const int lo = args.ph_lo, hi = args.ph_hi;
    const bool use_bar = (hi - lo) > 1;
    XcdBarrier bar; bar.bar = (unsigned*)(ctl + CW_BAR); bar.x = 0; bar.st = nullptr;
    if (use_bar) bar = xcd_barrier_post((unsigned*)(ctl + CW_BAR), MISC + 8);
#ifndef PROBE_PHASE
#define PROBE_PHASE -1
#endif
#define REP(k) for (int rep_ = 0; rep_ < ((PROBE_PHASE == (k)) ? 2 : 1); ++rep_)
#define IN(k) (lo <= (k) && (k) < hi)
#define SEAM(k) do { if (IN(k) && IN((k) + 1)) xcd_barrier(bar); } while (0)

    if (IN(0)) REP(0) {
        for (int it = gw; it < 32 * 86; it += NGW) { const int kh = it / 86, cb = it - kh * 86, kb = 2 * kh;
            const float* src = w_up + (size_t)(64 * kb) * NUP + 256 * cb + 4 * lane; f32x4 mx = (f32x4){0.f, 0.f, 0.f, 0.f};
#pragma unroll 1
            for (int b = 0; b < 4; ++b) { f32x4 t[16];
#pragma unroll
                for (int i = 0; i < 16; ++i) t[i] = __builtin_nontemporal_load((const GAS f32x4*)(src + (size_t)(16 * b + i) * NUP));
#pragma unroll
                for (int i = 0; i < 16; ++i) { const float gk = fabsf(ffn_g[64 * kb + 16 * b + i]);
                    mx.x = fmaxf(mx.x, fabsf(t[i].x) * gk); mx.y = fmaxf(mx.y, fabsf(t[i].y) * gk); mx.z = fmaxf(mx.z, fabsf(t[i].z) * gk); mx.w = fmaxf(mx.w, fabsf(t[i].w) * gk); } }
            *(GAS f32x4*)(CMAXP + (size_t)kb * NUP + 256 * cb + 4 * lane) = mx; }
        for (int it = gw; it < 32 * NI8T; it += NGW) { const int kh = it / NI8T, cb = it - kh * NI8T, kb = 2 * kh;
            const float* src = w_in + (size_t)(64 * kb) * 12320 + in_src_col(256 * cb) + 4 * lane; float m0 = 0.f, m1 = 0.f, m2 = 0.f, m3 = 0.f;
#pragma unroll 1
            for (int b = 0; b < 4; ++b) { f32x4 t[16];
#pragma unroll
                for (int i = 0; i < 16; ++i) t[i] = __builtin_nontemporal_load((const GAS f32x4*)(src + (size_t)(16 * b + i) * 12320));
#pragma unroll
                for (int i = 0; i < 16; ++i) { m0 = fmaxf(m0, fabsf(t[i].x)); m1 = fmaxf(m1, fabsf(t[i].y)); m2 = fmaxf(m2, fabsf(t[i].z)); m3 = fmaxf(m3, fabsf(t[i].w)); } }
            unsigned* cm = (unsigned*)CMI + 256 * cb + 4 * lane;
            __hip_atomic_fetch_max(cm + 0, __builtin_bit_cast(unsigned, m0), __ATOMIC_RELAXED, __HIP_MEMORY_SCOPE_AGENT); __hip_atomic_fetch_max(cm + 1, __builtin_bit_cast(unsigned, m1), __ATOMIC_RELAXED, __HIP_MEMORY_SCOPE_AGENT);
            __hip_atomic_fetch_max(cm + 2, __builtin_bit_cast(unsigned, m2), __ATOMIC_RELAXED, __HIP_MEMORY_SCOPE_AGENT); __hip_atomic_fetch_max(cm + 3, __builtin_bit_cast(unsigned, m3), __ATOMIC_RELAXED, __HIP_MEMORY_SCOPE_AGENT); }
        for (int m = gw; m < MP; m += NGW) {
            if (m < MTOK) { const float* xr = m < 8192 ? x_prompt + (size_t)m * DM : (m < 16384 ? x_sample + (size_t)(m - 8192) * DM : meta + (size_t)((m - 16384) & 15) * DM);
                norm_row_q(xr, mix_g, XN + (size_t)m * DM, XQ + (size_t)m * DM, RFI + m, lane); }
            else { GAS v4u* o = (GAS v4u*)(XN + (size_t)m * DM) + lane; GAS u32x2v* oq = (GAS u32x2v*)(XQ + (size_t)m * DM) + lane;
#pragma unroll
                for (int j = 0; j < 8; ++j) { o[64 * j] = (v4u){0u, 0u, 0u, 0u}; oq[64 * j] = (u32x2v){0u, 0u}; }
                if (lane == 0) RFI[m] = 0.f; }
        }
    }
    SEAM(0);
    if (IN(1)) REP(1) {
        LAS float* scr = (LAS float*)(lds + wave * 16384);
        { CvRegs va, vb; int it = gw;
          if (it < CV_I_I) { CvDesc da = cv_desc_in(it, w_in, ffn_g, CMI, WI); cv_load(da, va, lane);
              for (;;) { const int itb = it + NGW; CvDesc db = da; if (itb < CV_I_I) { db = cv_desc_in(itb, w_in, ffn_g, CMI, WI); cv_load(db, vb, lane); }
                  cv_finish(da, va, scr, lane); if (itb >= CV_I_I) break;
                  it = itb + NGW; if (it < CV_I_I) { da = cv_desc_in(it, w_in, ffn_g, CMI, WI); cv_load(da, va, lane); }
                  cv_finish(db, vb, scr, lane); if (it >= CV_I_I) break; } } }
    }
    SEAM(1);
    if (IN(2)) REP(2) {
        { pg8::Gemm g{(const bf16*)XQ, (const bf16*)WI8, MREAL, NI8C, DM / 2}; pg8::StaticOrder S; S.init(MREAL, NI8C, G, bid);
          pg8::EpiIn8 E{PQK, PV, PR, RFI, CMI};
          pg8::gemm_phase<pg8::EpiIn8, pg8::StaticOrder, true, true, 0, true>(lds, g, S, E); }
        __syncthreads();
        { pg8::Gemm g{XN, WI + (size_t)NI8C * DM, MREAL, 12288 - NI8C, DM}; pg8::StaticOrder S; S.init(MREAL, 12288 - NI8C, G, bid);
          pg8::EpiIn E{PQK, PV, PR, PC, AD, NI8T};
          pg8::gemm_phase<pg8::EpiIn, pg8::StaticOrder, true, true>(lds, g, S, E); }
        { const int fr = lane & 15, fq = lane >> 4;
          for (int blk = bid; blk < MREAL / 64; blk += G) { const int r0 = 64 * blk + 16 * (wave >> 1), c0 = 16 * (wave & 1);
              const f32x4 d = thin_tile(XN + (size_t)(r0 + fr) * DM, WI + (size_t)(12288 + c0 + fr) * DM, fq);
#pragma unroll
              for (int r = 0; r < 4; ++r) AD[(size_t)(r0 + 4 * fq + r) * 32 + c0 + fr] = d[r]; }
          for (int t = gw; t < 770; t += NGW) { const int n0 = 16 * t; f32x4 d;
              const bool paired = n0 >= 8192 && n0 < 12288;
              if (paired && ((n0 - 8192) & 128)) continue;
              if (n0 < NI8C) { const pg8::i32x4 di = thin_tile_i8(XQ + (size_t)(MREAL + fr) * DM, WI8 + (size_t)(n0 + fr) * DM, fq); const float cf = CMI[n0 + fr] * (WQ_HEAD / 127.0f);
#pragma unroll
                  for (int r = 0; r < 4; ++r) d[r] = (float)di[r] * (RFI[MREAL + 4 * fq + r] * cf); }
              else d = thin_tile(XN + (size_t)(MREAL + fr) * DM, WI + (size_t)(n0 + fr) * DM, fq);
              if (paired) d = d * thin_tile(XN + (size_t)(MREAL + fr) * DM, WI + (size_t)(n0 + 128 + fr) * DM, fq);
              const int n = n0 + fr;
#pragma unroll
              for (int r = 0; r < 4; ++r) { const int i = 4 * fq + r;
                  if (n0 >= 12288) {
#pragma unroll
                      for (int s6 = 0; s6 < 6; ++s6) AD[(size_t)(MREAL + 16 * s6 + i) * 32 + (n - 12288)] = d[r]; }
                  else { bf16* base; int ldc, col; if (n0 < 2048) { base = PV; ldc = 2048; col = n; } else if (n0 < 4096) { base = PR; ldc = 2048; col = n - 2048; } else if (n0 < 6144) { base = PQK; ldc = 2048; col = n - 4096; } else if (n0 < 8192) { base = PC; ldc = 4096; col = n - 6144; } else { base = PC; ldc = 4096; col = 2048 + 128 * ((n0 - 8192) >> 8) + ((n0 - 8192) & 127) + fr; }
                      const unsigned short hv = (unsigned short)(cvtpk(d[r], 0.f) & 0xffffu);
#pragma unroll
                      for (int s6 = 0; s6 < 6; ++s6) base[(size_t)(MREAL + 16 * s6 + i) * ldc + col] = hv; } } } }
    }
    SEAM(2);
    if (IN(3)) REP(3) {
        for (int n = bid * 512 + tid; n < NUP; n += G * 512) { float m = 0.f;
#pragma unroll 8
            for (int kb = 0; kb < 64; kb += 2) m = fmaxf(m, CMAXP[(size_t)kb * NUP + n]);
            CS[n] = m * (WQ_HEAD / 127.0f); }
        for (int it = bid; it < NITEM + NCONV; it += G) {
            if (it < NITEM) prep_item<0>(it, lds, AD, PQK, PV, wg2, bg2, QT, KT, KH, ED, VT, tid, wave, lane);
            else conv_item(it - NITEM, PC, cmw, MIX, tid);
        }
#if PROBE_PHASE == 21
        for (int it = NITEM + bid; it < NITEM + NCONV; it += G) conv_item(it - NITEM, PC, cmw, MIX, tid);
#elif PROBE_PHASE >= 22 && PROBE_PHASE <= 29
        for (int it = bid; it < NITEM; it += G) prep_item<PROBE_PHASE - 22>(it, lds, AD, PQK, PV, wg2, bg2, QT, KT, KH, ED, VT, tid, wave, lane);
#endif
    }
    SEAM(3);
    if (IN(4)) REP(4) {
        for (int it = bid; it < 192; it += G) scan_item<0>(it, lds, QT, KT, KH, ED, VT, O2, tid, wave, lane);
        { LAS float* scr = (LAS float*)(lds + wave * 16384); CvRegs va, vb, vc, vd;
          for (;;) { int base = 0; if (lane == 0) base = (int)__hip_atomic_fetch_add(ctl + CW_Q, 16u, __ATOMIC_RELAXED, __HIP_MEMORY_SCOPE_AGENT);
              base = __builtin_amdgcn_readfirstlane(base); if (base >= CV_I_REST) break;
              CvDesc da = cv_desc_rest(base, w_out, w_up, w_down, ffn_g, CS, WO, WU, WD), db = cv_desc_rest(base + 1, w_out, w_up, w_down, ffn_g, CS, WO, WU, WD), dc = cv_desc_rest(base + 2, w_out, w_up, w_down, ffn_g, CS, WO, WU, WD), dd = cv_desc_rest(base + 3, w_out, w_up, w_down, ffn_g, CS, WO, WU, WD);
              cv_load(da, va, lane); cv_load(db, vb, lane); cv_load(dc, vc, lane); cv_load(dd, vd, lane);
              for (int it = base; it < base + 16; it += 4) { const bool more = it + 4 < base + 16;
                  cv_finish(da, va, scr, lane); if (more) { da = cv_desc_rest(it + 4, w_out, w_up, w_down, ffn_g, CS, WO, WU, WD); cv_load(da, va, lane); }
                  cv_finish(db, vb, scr, lane); if (more) { db = cv_desc_rest(it + 5, w_out, w_up, w_down, ffn_g, CS, WO, WU, WD); cv_load(db, vb, lane); }
                  cv_finish(dc, vc, scr, lane); if (more) { dc = cv_desc_rest(it + 6, w_out, w_up, w_down, ffn_g, CS, WO, WU, WD); cv_load(dc, vc, lane); }
                  cv_finish(dd, vd, scr, lane); if (more) { dd = cv_desc_rest(it + 7, w_out, w_up, w_down, ffn_g, CS, WO, WU, WD); cv_load(dd, vd, lane); } } } }
    }
    SEAM(4);
    if (IN(5)) REP(5) {
        const f32x4 g4 = *(const GAS f32x4*)(hng + 4 * lane);
        for (int wi = gw; wi < MTOK * 8; wi += NGW) { const int row = wi >> 3, h = wi & 7;
            const u32x2v a = *(const GAS u32x2v*)(O2 + (size_t)row * 2048 + h * 256 + 4 * lane), b = *(const GAS u32x2v*)(O2 + ((size_t)MP + row) * 2048 + h * 256 + 4 * lane);
            const u32x2v rw = *(const GAS u32x2v*)(PR + (size_t)row * 2048 + h * 256 + 4 * lane);
            const float o0 = bflo(a.x) + bflo(b.x), o1 = bfhi(a.x) + bfhi(b.x), o2 = bflo(a.y) + bflo(b.y), o3 = bfhi(a.y) + bfhi(b.y);
            const float rs = 1.0f / sqrtf(wave_sum((o0 * o0 + o1 * o1) + (o2 * o2 + o3 * o3)) * (1.0f / 256.0f) + EPS);
            const float r0 = bflo(rw.x), r1 = bfhi(rw.x), r2 = bflo(rw.y), r3 = bfhi(rw.y);
            const float y0 = o0 * rs * g4.x * (r0 / (1.0f + expf(-r0))), y1 = o1 * rs * g4.y * (r1 / (1.0f + expf(-r1))), y2 = o2 * rs * g4.z * (r2 / (1.0f + expf(-r2))), y3 = o3 * rs * g4.w * (r3 / (1.0f + expf(-r3)));
            *(GAS u32x2v*)(MIX + (size_t)row * 4096 + h * 256 + 4 * lane) = (u32x2v){cvtpk(y0, y1), cvtpk(y2, y3)}; }
    }
    SEAM(5);
    if (IN(6)) REP(6) {
        pg8::Gemm g{MIX, WO, MREAL, DM, DM}; pg8::StaticOrder S; S.init(MREAL, DM, G, bid);
        pg8::EpiOut E{x_prompt, x_sample, XN, SSQ};
        pg8::gemm_phase<pg8::EpiOut, pg8::StaticOrder, true, true>(lds, g, S, E);
        __syncthreads();
        pg8::Gemm g2{MIX, WO, MP, DM, 256, DM}; pg8::MiniOrder S2{64, 16, 16, G, bid};
        pg8::EpiPart E2{PART};
        pg8::gemm_phase<pg8::EpiPart, pg8::MiniOrder, true, true>(lds, g2, S2, E2);
    }
    SEAM(6);
    if (IN(7)) REP(7) {
        for (int m = gw; m < MREAL; m += NGW) {
            const float sv = SSQ[(size_t)m * 64 + lane]; v4u w[8];
#pragma unroll
            for (int j = 0; j < 8; ++j) w[j] = *(const GAS v4u*)(XN + (size_t)m * DM + 8 * lane + 512 * j);
            const float rstd = 1.0f / sqrtf(wave_sum(sv) * (1.0f / 4096.0f) + EPS);
            float amax = 0.f;
#pragma unroll
            for (int j = 0; j < 8; ++j) { amax = fmaxf(amax, fmaxf(fmaxf(fabsf(bflo(w[j].x)), fabsf(bfhi(w[j].x))), fmaxf(fabsf(bflo(w[j].y)), fabsf(bfhi(w[j].y)))));
                                          amax = fmaxf(amax, fmaxf(fmaxf(fabsf(bflo(w[j].z)), fabsf(bfhi(w[j].z))), fmaxf(fabsf(bflo(w[j].w)), fabsf(bfhi(w[j].w))))); }
            amax = wave_max(amax); const float sc = amax > 0.f ? 127.0f / amax : 0.f;
#pragma unroll
            for (int j = 0; j < 8; ++j) { u32x2v o; o.x = q8x4(bflo(w[j].x) * sc, bfhi(w[j].x) * sc, bflo(w[j].y) * sc, bfhi(w[j].y) * sc); o.y = q8x4(bflo(w[j].z) * sc, bfhi(w[j].z) * sc, bflo(w[j].w) * sc, bfhi(w[j].w) * sc);
                *(GAS u32x2v*)(XQ + (size_t)m * DM + 8 * lane + 512 * j) = o; }
            if (lane == 0) RSTD[m] = amax * (1.0f / 127.0f) * rstd;
        }
        for (int m = MREAL + gw; m < MP; m += NGW) {
            if (m < MTOK) { const int r = m - MREAL; float ss = 0.f, amax = 0.f;
#pragma unroll 2
                for (int j = 0; j < 8; ++j) { const int col = 8 * lane + 512 * j; const GAS f32x4* mp = (const GAS f32x4*)(meta + (size_t)(r & 15) * DM + col); f32x4 a = mp[0], b = mp[1];
#pragma unroll
                    for (int ks = 0; ks < 16; ++ks) { const GAS f32x4* pp = (const GAS f32x4*)(PART + ((size_t)ks * 96 + r) * DM + col); a += pp[0]; b += pp[1]; }
                    GAS f32x4* xo = (GAS f32x4*)(X1M + (size_t)r * DM + col); xo[0] = a; xo[1] = b;
                    ss += (a.x * a.x + a.y * a.y) + (a.z * a.z + a.w * a.w) + (b.x * b.x + b.y * b.y) + (b.z * b.z + b.w * b.w);
                    v4u o; o.x = cvtpk(a.x, a.y); o.y = cvtpk(a.z, a.w); o.z = cvtpk(b.x, b.y); o.w = cvtpk(b.z, b.w); *(GAS v4u*)(XN + (size_t)m * DM + col) = o;
                    amax = fmaxf(amax, fmaxf(fmaxf(fabsf(bflo(o.x)), fabsf(bfhi(o.x))), fmaxf(fabsf(bflo(o.y)), fabsf(bfhi(o.y)))));
                    amax = fmaxf(amax, fmaxf(fmaxf(fabsf(bflo(o.z)), fabsf(bfhi(o.z))), fmaxf(fabsf(bflo(o.w)), fabsf(bfhi(o.w))))); }
                const float rr = 1.0f / sqrtf(wave_sum(ss) * (1.0f / 4096.0f) + EPS);
                amax = wave_max(amax); const float sc = amax > 0.f ? 127.0f / amax : 0.f;
#pragma unroll 2
                for (int j = 0; j < 8; ++j) { const int col = 8 * lane + 512 * j; const v4u w = *(const GAS v4u*)(XN + (size_t)m * DM + col);
                    u32x2v o; o.x = q8x4(bflo(w.x) * sc, bfhi(w.x) * sc, bflo(w.y) * sc, bfhi(w.y) * sc); o.y = q8x4(bflo(w.z) * sc, bfhi(w.z) * sc, bflo(w.w) * sc, bfhi(w.w) * sc);
                    *(GAS u32x2v*)(XQ + (size_t)m * DM + col) = o; }
                if (lane == 0) RSTD[m] = amax * (1.0f / 127.0f) * rr; }
            else {
#pragma unroll
                for (int j = 0; j < 8; ++j) *(GAS u32x2v*)(XQ + (size_t)m * DM + 8 * lane + 512 * j) = (u32x2v){0u, 0u};
                if (lane == 0) RSTD[m] = 0.f; }
        }
    }
    SEAM(7);
    if (IN(8)) REP(8) {
        pg8::Gemm g{(const bf16*)XQ, (const bf16*)WU, MP, NUP, DM / 2}; pg8::StaticOrder S; S.init(MP, NUP, G, bid);
        pg8::EpiUpFused E{HB, RSTD, CS, fcw, fcb, EP, EG, EU, EGM, (LAS float*)(lds + RING_BYTES + 4096)};
        pg8::gemm_phase<pg8::EpiUpFused, pg8::StaticOrder, true, true, 0, true>(lds, g, S, E);
#if PROBE_PHASE >= 70 && PROBE_PHASE <= 89
        { pg8::EpiNull EN; pg8::gemm_phase<pg8::EpiNull, pg8::StaticOrder, true, true, PROBE_PHASE - 70>(lds, g, S, EN); }
#endif
    }
    SEAM(8);
    if (IN(9)) REP(9) {
        for (int q = bid * 512 + tid; q < 128 * 1376; q += G * 512) fixup_item(q, EP, EG, EU, EGM, fcw, HB);
    }
    SEAM(9);
    if (IN(10)) REP(10) {
        pg8::Gemm g{HB, WD, MREAL, DM, DFF}; pg8::StaticOrder S; S.init(MREAL, DM, G, bid);
        pg8::EpiDown E{XN};
        pg8::gemm_phase<pg8::EpiDown, pg8::StaticOrder, true, true>(lds, g, S, E);
    }
    SEAM(10);
    if (IN(11)) REP(11) {
        for (int m = gw; m < MREAL; m += NGW) {
            float v[8][8]; float s = 0.f;
#pragma unroll
            for (int j = 0; j < 8; ++j) { const v4u w = *(const GAS v4u*)(XN + (size_t)m * DM + 8 * lane + 512 * j);
                v[j][0] = bflo(w.x); v[j][1] = bfhi(w.x); v[j][2] = bflo(w.y); v[j][3] = bfhi(w.y); v[j][4] = bflo(w.z); v[j][5] = bfhi(w.z); v[j][6] = bflo(w.w); v[j][7] = bfhi(w.w);
#pragma unroll
                for (int e = 0; e < 8; ++e) s += v[j][e] * v[j][e]; }
            const float rstd = 1.0f / sqrtf(wave_sum(s) * (1.0f / 4096.0f) + EPS);
#pragma unroll
            for (int j = 0; j < 8; ++j) { const GAS f32x4* gp = (const GAS f32x4*)(fin_g + 8 * lane + 512 * j); const f32x4 g0 = gp[0], g1 = gp[1];
                GAS f32x4* op = (GAS f32x4*)(out + (size_t)m * DM + 8 * lane + 512 * j);
                op[0] = (f32x4){v[j][0] * rstd * g0.x, v[j][1] * rstd * g0.y, v[j][2] * rstd * g0.z, v[j][3] * rstd * g0.w};
                op[1] = (f32x4){v[j][4] * rstd * g1.x, v[j][5] * rstd * g1.y, v[j][6] * rstd * g1.z, v[j][7] * rstd * g1.w}; } }
    }
#undef IN
#undef SEAM
}

extern "C" void kernel_launch(void* const* d_in, const int* in_sizes, int n_in, void* d_out, int out_size, void* d_ws, size_t ws_size, hipStream_t stream) {
    static int grid = 0;
    if (grid == 0) {
        if (n_in != 16 || ws_size < WS_END) { fprintf(stderr, "kernel_launch: unexpected n_in %d / ws_size %zu (need %zu)\n", n_in, ws_size, (size_t)WS_END); grid = -1; return; }
        int dev = 0, cus = 0, per_cu = 0;
        if (hipGetDevice(&dev) != hipSuccess || hipDeviceGetAttribute(&cus, hipDeviceAttributeMultiprocessorCount, dev) != hipSuccess) { grid = -1; return; }
        if (hipFuncSetAttribute((const void*)fwd, hipFuncAttributeMaxDynamicSharedMemorySize, LDS_BYTES) != hipSuccess) { fprintf(stderr, "kernel_launch: hipFuncSetAttribute failed\n"); grid = -1; return; }
        if (hipOccupancyMaxActiveBlocksPerMultiprocessor(&per_cu, (const void*)fwd, NWAVES * 64, LDS_BYTES) != hipSuccess || per_cu < 1) { fprintf(stderr, "kernel_launch: occupancy query says %d\n", per_cu); }
        (void)hipGetLastError();
        grid = cus;
    }
    if (grid < 0) return;
    (void)hipMemsetAsync((char*)d_ws + WS_CTL, 0, CTL_ZERO_BYTES, stream);
    Args a{};
    for (int i = 0; i < 16; ++i) a.in[i] = (const float*)d_in[i];
    a.out = (float*)d_out; a.ws = (unsigned char*)d_ws;
#if MK_ONE_LAUNCH
    a.ph_lo = 0; a.ph_hi = NPHASE;
    hipLaunchKernelGGL(fwd, dim3(grid), dim3(NWAVES * 64), LDS_BYTES, stream, a);
#else
    for (int p = 0; p < NPHASE; ++p) { a.ph_lo = p; a.ph_hi = p + 1; hipLaunchKernelGGL(fwd, dim3(grid), dim3(NWAVES * 64), LDS_BYTES, stream, a); }
#endif
}
```
